# Optimizing an MI355X kernel written in HIP

```python
import math
import jax
import jax.numpy as jnp
from jax import lax
import numpy as np

D_MODEL = 1024
BATCH = 2
SEQ = 16384
DEPTH = 4

DA_HEAD_DIM = 128
DA_HEADS = D_MODEL // (2 * DA_HEAD_DIM)
SW_HEAD_DIM = 64
SW_HEADS = D_MODEL // SW_HEAD_DIM
SW_KV_HEADS = SW_HEADS // 8
WINDOW = 128
Q_BLOCK = 128
N_EXPERTS = 32
TOP_K = 4
D_FF = D_MODEL
SWIGLU_LIMIT = 7.0
SWIGLU_ALPHA = 1.702
MOE_BLOCK = 256
LN_EPS = 1e-5
DEEPNORM_ALPHA = (2.0 * DEPTH) ** 0.25
DEEPNORM_BETA = (8.0 * DEPTH) ** -0.25
NEG_INF = -1e30
DA_QK_COLS = DA_HEADS * 2 * DA_HEAD_DIM
DA_V_COLS = DA_HEADS * 2 * DA_HEAD_DIM
SW_Q_COLS = SW_HEADS * SW_HEAD_DIM
SW_KV_COLS = SW_KV_HEADS * SW_HEAD_DIM
D_IN = 2 * DA_QK_COLS + DA_V_COLS + SW_Q_COLS + 2 * SW_KV_COLS + 2 * D_MODEL

kernel_name = 'hybrid_diffattn_swa_moe_deepnorm'


def _alibi_slopes(n):
    return 2.0 ** (-8.0 * jnp.arange(1, n + 1, dtype=jnp.float32) / n)


def _layer_norm(x, g, b):
    xf = x.astype(jnp.float32)
    mu = jnp.mean(xf, axis=-1, keepdims=True)
    var = jnp.mean(jnp.square(xf - mu), axis=-1, keepdims=True)
    y = (xf - mu) * lax.rsqrt(var + LN_EPS) * g.astype(jnp.float32) + b.astype(jnp.float32)
    return y.astype(x.dtype)


def _diff_attention(q, k, v, lam, lam_init, subln_g):
    B, S = q.shape[0], q.shape[1]
    n_qb = S // Q_BLOCK
    slopes = _alibi_slopes(DA_HEADS)
    scale = DA_HEAD_DIM ** -0.5
    q_blocks = q.reshape(B, n_qb, Q_BLOCK, DA_HEADS, 2, DA_HEAD_DIM).transpose(1, 0, 2, 3, 4, 5)
    kpos = jnp.arange(S, dtype=jnp.int32)

    def one_block(args):
        qb, i = args
        s = jnp.einsum('bqhcd,bkhcd->bhcqk', qb, k, preferred_element_type=jnp.float32) * scale
        qpos = i * Q_BLOCK + jnp.arange(Q_BLOCK, dtype=jnp.int32)
        dist = qpos[:, None] - kpos[None, :]
        s = s - slopes[:, None, None, None] * dist.astype(jnp.float32)
        s = jnp.where(dist >= 0, s, NEG_INF)
        p = jax.nn.softmax(s, axis=-1)
        a = p[:, :, 0] - lam * p[:, :, 1]
        return jnp.einsum('bhqk,bkhe->bqhe', a.astype(v.dtype), v)

    o = lax.map(one_block, (q_blocks, jnp.arange(n_qb, dtype=jnp.int32)))
    o = o.transpose(1, 0, 2, 3, 4).reshape(B, S, DA_HEADS, 2 * DA_HEAD_DIM)
    of = o.astype(jnp.float32)
    of = of * lax.rsqrt(jnp.mean(jnp.square(of), axis=-1, keepdims=True) + LN_EPS)
    of = of * subln_g.astype(jnp.float32) * (1.0 - lam_init)
    return of.reshape(B, S, DA_HEADS * 2 * DA_HEAD_DIM).astype(v.dtype)


def _band(t, n_blocks):
    B = t.shape[0]
    tb = t.reshape(B, n_blocks, WINDOW, SW_KV_HEADS, SW_HEAD_DIM)
    prev = jnp.concatenate([jnp.zeros_like(tb[:, :1]), tb[:, :-1]], axis=1)
    return jnp.concatenate([prev, tb], axis=2)


def _sliding_window_attention(q, k, v, sinks):
    B, S = q.shape[0], q.shape[1]
    G = SW_HEADS // SW_KV_HEADS
    nb = S // WINDOW
    qb = q.reshape(B, nb, WINDOW, SW_KV_HEADS, G, SW_HEAD_DIM)
    kk = _band(k, nb)
    vv = _band(v, nb)
    s = jnp.einsum('bnqkgd,bnjkd->bnkgqj', qb, kk, preferred_element_type=jnp.float32) * (SW_HEAD_DIM ** -0.5)
    qi = jnp.arange(WINDOW, dtype=jnp.int32)
    kj = jnp.arange(2 * WINDOW, dtype=jnp.int32)
    dist = qi[:, None] + WINDOW - kj[None, :]
    key_global = jnp.arange(nb, dtype=jnp.int32)[:, None] * WINDOW + kj[None, :] - WINDOW
    valid = ((dist >= 0) & (dist < WINDOW))[None] & (key_global >= 0)[:, None, :]
    slopes = _alibi_slopes(SW_HEADS).reshape(SW_KV_HEADS, G)
    s = s - slopes[:, :, None, None] * dist.astype(jnp.float32)
    s = jnp.where(valid[:, None, None], s, NEG_INF)
    sink = jnp.broadcast_to(sinks.astype(jnp.float32).reshape(SW_KV_HEADS, G)[:, :, None, None], s.shape[:-1] + (1,))
    p = jax.nn.softmax(jnp.concatenate([s, sink], axis=-1), axis=-1)[..., :-1]
    o = jnp.einsum('bnkgqj,bnjkd->bnqkgd', p.astype(v.dtype), vv)
    return o.reshape(B, S, SW_HEADS * SW_HEAD_DIM)


def _hybrid_mixer(x, w_in, w_o, lambda_qk, subln_g, sinks, layer):
    B, S, _ = x.shape
    proj = x @ w_in
    offs = np.cumsum([DA_QK_COLS, DA_QK_COLS, DA_V_COLS, SW_Q_COLS, SW_KV_COLS, SW_KV_COLS, D_MODEL]).tolist()
    qa, ka, va, qb, kb, vb, ga, gb = jnp.split(proj, offs, axis=-1)
    qa = qa.reshape(B, S, DA_HEADS, 2, DA_HEAD_DIM)
    ka = ka.reshape(B, S, DA_HEADS, 2, DA_HEAD_DIM)
    va = va.reshape(B, S, DA_HEADS, 2 * DA_HEAD_DIM)
    lam_init = 0.8 - 0.6 * math.exp(-0.3 * layer)
    lq = lambda_qk.astype(jnp.float32)
    lam = jnp.exp(jnp.sum(lq[0] * lq[1])) - jnp.exp(jnp.sum(lq[2] * lq[3])) + lam_init
    o_a = _diff_attention(qa, ka, va, lam, lam_init, subln_g)
    o_b = _sliding_window_attention(
        qb.reshape(B, S, SW_HEADS, SW_HEAD_DIM),
        kb.reshape(B, S, SW_KV_HEADS, SW_HEAD_DIM),
        vb.reshape(B, S, SW_KV_HEADS, SW_HEAD_DIM),
        sinks)
    merged = jax.nn.sigmoid(ga) * o_a + jax.nn.sigmoid(gb) * o_b
    return merged @ w_o


def _moe(x, w_router, b_router, w_up, b_up, w_down, b_down):
    B, S, D = x.shape
    T = B * S
    TK = T * TOP_K
    xt = x.reshape(T, D)
    logits = jnp.dot(xt, w_router, preferred_element_type=jnp.float32) + b_router.astype(jnp.float32)
    top_val, top_idx = lax.top_k(logits, TOP_K)
    gates = jax.nn.softmax(top_val, axis=-1)
    flat_e = top_idx.reshape(TK).astype(jnp.int32)
    flat_tok = jnp.arange(TK, dtype=jnp.int32) // TOP_K
    flat_gate = gates.reshape(TK)
    order = jnp.argsort(flat_e)
    e_s = flat_e[order]
    tok_s = flat_tok[order]
    gate_s = flat_gate[order]
    counts = jnp.bincount(flat_e, length=N_EXPERTS).astype(jnp.int32)
    padded = (counts + MOE_BLOCK - 1) // MOE_BLOCK * MOE_BLOCK
    pad_end = jnp.cumsum(padded)
    pad_start = pad_end - padded
    start = jnp.cumsum(counts) - counts
    dest = pad_start[e_s] + jnp.arange(TK, dtype=jnp.int32) - start[e_s]
    n_blocks = (TK + N_EXPERTS * (MOE_BLOCK - 1) + MOE_BLOCK - 1) // MOE_BLOCK
    n_rows = n_blocks * MOE_BLOCK
    buf_tok = jnp.zeros((n_rows,), jnp.int32).at[dest].set(tok_s)
    buf_gate = jnp.zeros((n_rows,), jnp.float32).at[dest].set(gate_s)
    block_expert = jnp.minimum(
        jnp.searchsorted(pad_end, jnp.arange(n_blocks, dtype=jnp.int32) * MOE_BLOCK, side='right'),
        N_EXPERTS - 1).astype(jnp.int32)
    xb = xt[buf_tok].reshape(n_blocks, MOE_BLOCK, D)

    def expert_block(args):
        xblk, e = args
        h = xblk @ w_up[e] + b_up[e]
        gate = jnp.minimum(h[..., ::2], SWIGLU_LIMIT)
        up = jnp.clip(h[..., 1::2], -SWIGLU_LIMIT, SWIGLU_LIMIT)
        act = (up + 1.0) * (gate * jax.nn.sigmoid(SWIGLU_ALPHA * gate))
        return act @ w_down[e] + b_down[e]

    yb = lax.map(expert_block, (xb, block_expert)).reshape(n_rows, D)
    y = jnp.zeros((T, D), x.dtype).at[buf_tok].add(yb * buf_gate[:, None].astype(x.dtype))
    return y.reshape(B, S, D)


def setup_inputs(seed: int = 0) -> dict:
    key = jax.random.key(seed)
    ks = jax.random.split(key, 14)
    f32 = jnp.float32
    x = jax.random.normal(ks[0], (BATCH, SEQ, D_MODEL), f32)
    col_scale = jnp.concatenate([
        jnp.ones((2 * DA_QK_COLS,), f32),
        jnp.full((DA_V_COLS,), DEEPNORM_BETA, f32),
        jnp.ones((SW_Q_COLS + SW_KV_COLS,), f32),
        jnp.full((SW_KV_COLS,), DEEPNORM_BETA, f32),
        jnp.ones((2 * D_MODEL,), f32)])
    w_in = jax.random.normal(ks[1], (DEPTH, D_MODEL, D_IN), f32) * (D_MODEL ** -0.5) * col_scale
    w_o = jax.random.normal(ks[2], (DEPTH, D_MODEL, D_MODEL), f32) * (D_MODEL ** -0.5) * DEEPNORM_BETA
    lambda_qk = jax.random.normal(ks[3], (DEPTH, 4, DA_HEAD_DIM), f32) * 0.1
    subln_g = 1.0 + 0.02 * jax.random.normal(ks[4], (DEPTH, 2 * DA_HEAD_DIM), f32)
    sinks = 0.5 * jax.random.normal(ks[5], (DEPTH, SW_HEADS), f32)
    ln_g = 1.0 + 0.02 * jax.random.normal(ks[6], (DEPTH, 2, D_MODEL), f32)
    ln_b = 0.02 * jax.random.normal(ks[7], (DEPTH, 2, D_MODEL), f32)
    w_router = jax.random.normal(ks[8], (DEPTH, D_MODEL, N_EXPERTS), f32) * (D_MODEL ** -0.5)
    b_router = 0.01 * jax.random.normal(ks[9], (DEPTH, N_EXPERTS), f32)
    w_up = jax.random.normal(ks[10], (DEPTH, N_EXPERTS, D_MODEL, 2 * D_FF), f32) * (D_MODEL ** -0.5) * DEEPNORM_BETA
    b_up = 0.01 * jax.random.normal(ks[11], (DEPTH, N_EXPERTS, 2 * D_FF), f32)
    w_down = jax.random.normal(ks[12], (DEPTH, N_EXPERTS, D_FF, D_MODEL), f32) * (D_FF ** -0.5) * DEEPNORM_BETA
    b_down = 0.01 * jax.random.normal(ks[13], (DEPTH, N_EXPERTS, D_MODEL), f32)
    return {'x': x, 'w_in': w_in, 'w_o': w_o, 'lambda_qk': lambda_qk, 'subln_g': subln_g,
            'sinks': sinks, 'ln_g': ln_g, 'ln_b': ln_b, 'w_router': w_router, 'b_router': b_router,
            'w_up': w_up, 'b_up': b_up, 'w_down': w_down, 'b_down': b_down}


def reference(x, w_in, w_o, lambda_qk, subln_g, sinks, ln_g, ln_b, w_router, b_router, w_up, b_up, w_down, b_down):
    for l in range(DEPTH):
        mix = _hybrid_mixer(x, w_in[l], w_o[l], lambda_qk[l], subln_g[l], sinks[l], l)
        h = _layer_norm(DEEPNORM_ALPHA * x + mix, ln_g[l, 0], ln_b[l, 0])
        ffn = _moe(h, w_router[l], b_router[l], w_up[l], b_up[l], w_down[l], b_down[l])
        x = _layer_norm(DEEPNORM_ALPHA * h + ffn, ln_g[l, 1], ln_b[l, 1])
    return x
```

```cpp
#include <hip/hip_runtime.h>
#include <cstdio>
#include <cstdint>

#ifndef MK_SINGLE
#define MK_SINGLE 0
#endif

constexpr int NB = 2, SEQ = 16384, DM = 1024, DEPTH = 4, TOK = NB * SEQ;
constexpr int DIN = 6400, NEXP = 32, TOPK = 4, DFF = 1024, TK = TOK * TOPK;
constexpr int C_QA = 0, C_KA = 1024, C_VA = 2048, C_QB = 3072, C_KB = 4096, C_VB = 4224, C_GA = 4352, C_GB = 5376;
constexpr int MAXBLK = 544;
constexpr float LN_EPS = 1e-5f;
constexpr float DN_ALPHA = 1.6817928305074290f;
constexpr float LOG2E = 1.4426950408889634f;
constexpr float QA_SCALE = 0.08838834764831845f * LOG2E;
constexpr float QB_SCALE = 0.125f * LOG2E;
constexpr float SW_LIMIT = 7.0f, SW_ALPHA = 1.702f;

namespace pg8 {
#define PG8_LAS __attribute__((address_space(3)))
typedef unsigned short bf16_t;
typedef short bf16x8 __attribute__((ext_vector_type(8)));
typedef float f32x4 __attribute__((ext_vector_type(4)));
typedef float f32x2 __attribute__((ext_vector_type(2)));
typedef unsigned u32x4 __attribute__((ext_vector_type(4)));
typedef unsigned u32x2 __attribute__((ext_vector_type(2)));
constexpr int BM = 256, BK = 64, HALF = 128, HTB = HALF * BK * 2  , STAGE_BYTES = 8 * HTB, NXCD = 8, WGM = 8;

__host__ __device__ __forceinline__ int lds_byte(int r, int c) { const int st = (r >> 4) * 2 + (c >> 5), rr = r & 15, cc = c & 31, ob = rr * 64 + cc * 2; return st * 1024 + (ob ^ (((ob >> 9) & 1) << 5)); }
__host__ __device__ __forceinline__ void stage_rc(int b, int& R, int& C) { const int st = b / 1024, sb = b % 1024, swz = sb ^ (((sb >> 9) & 1) << 5); R = (st >> 1) * 16 + swz / 64; C = (st & 1) * 32 + (swz % 64) / 2; }
__host__ __device__ __forceinline__ int perm32(int rho) { const int n = rho >> 4, i = rho & 15; return 8 * (i >> 2) + 4 * n + (i & 3); }

struct Unit { int pm, pn, e; };
struct Gemm { const bf16_t* A; const bf16_t* Bt; int M, N, K; size_t bstride; };

struct StaticOrder {
    int nM, nN, nwg, G, c; const int* blke;
    __device__ void init(int M, int N, int G_, int c_, const int* blke_) { nM = M / BM; nN = N / BM; nwg = nM * nN; G = G_; c = c_; blke = blke_; }
    __device__ bool next(int i, Unit& u) const {
        const long L = (long)i * G + c; if (L >= nwg) return false;
        int wgid = (int)L; { const int q = nwg / NXCD, r = nwg % NXCD, xcd = wgid % NXCD, off = wgid / NXCD; wgid = (xcd < r ? xcd * (q + 1) : r * (q + 1) + (xcd - r) * q) + off; }
        const int nig = WGM * nN, gid = wgid / nig, fm = gid * WGM, gsz = (nM - fm) < WGM ? (nM - fm) : WGM;
        u.pm = fm + ((wgid % nig) % gsz); u.pn = (wgid % nig) / gsz;
        u.e = blke ? __builtin_amdgcn_readfirstlane(__hip_atomic_load(blke + u.pm, __ATOMIC_RELAXED, __HIP_MEMORY_SCOPE_AGENT)) : 0;
        return true;
    }
    __device__ __forceinline__ void a_ready(const Unit&) const {}
    __device__ __forceinline__ void done(const Unit&) const {}
};

__device__ __forceinline__ int otid() { int t = threadIdx.x; asm volatile("" : "+v"(t)); return t; }
__device__ __forceinline__ unsigned cvt_pk_bf16(float lo, float hi) { unsigned r; asm volatile("v_cvt_pk_bf16_f32 %0, %1, %2" : "=v"(r) : "v"(lo), "v"(hi)); return r; }
__device__ __forceinline__ float fast_sigmoid(float x) { return __builtin_amdgcn_rcpf(1.0f + __builtin_amdgcn_exp2f(-x * 1.4426950408889634f)); }

struct EpiInProj {
    static constexpr bool PERM = true, AFTER_DRAIN = false;
    bf16_t* O;
    __device__ __forceinline__ void operator()(const f32x4 (&acc)[2][2][4][2], const Unit& u, int wr, int wc, int fr, int fq) const {
        const int row0 = u.pm * BM + wr * 64 + fr, col0 = u.pn * BM + wc * 32 + 8 * fq;
        const int pn = u.pn;
        const float sc = (pn < 4) ? QA_SCALE : ((pn >= 12 && pn < 16) ? QB_SCALE : 1.0f);
        const bool sig = pn >= 17;
#pragma unroll
        for (int ai = 0; ai < 2; ++ai)
#pragma unroll
            for (int m = 0; m < 4; ++m) { bf16_t* rowp = O + (size_t)(row0 + ai * HALF + m * 16) * DIN + col0;
#pragma unroll
                for (int bj = 0; bj < 2; ++bj) { f32x4 v0 = acc[ai][bj][m][0] * sc, v1 = acc[ai][bj][m][1] * sc;
                    if (sig) {
#pragma unroll
                        for (int q = 0; q < 4; ++q) { v0[q] = fast_sigmoid(v0[q]); v1[q] = fast_sigmoid(v1[q]); } }
                    u32x4 w; w.x = cvt_pk_bf16(v0[0], v0[1]); w.y = cvt_pk_bf16(v0[2], v0[3]); w.z = cvt_pk_bf16(v1[0], v1[1]); w.w = cvt_pk_bf16(v1[2], v1[3]);
                    *(u32x4*)(rowp + bj * HALF) = w; } }
    }
};
struct EpiF32 {
    static constexpr bool PERM = false, AFTER_DRAIN = false;
    float* O; int ldc; const float* bias; int bias_stride;
    __device__ __forceinline__ void operator()(const f32x4 (&acc)[2][2][4][2], const Unit& u, int wr, int wc, int fr, int fq) const {
        const int row0 = u.pm * BM + wr * 64 + fr, col0 = u.pn * BM + wc * 32 + 4 * fq;
        f32x4 bv[2][2];
#pragma unroll
        for (int bj = 0; bj < 2; ++bj)
#pragma unroll
            for (int n = 0; n < 2; ++n) bv[bj][n] = bias ? *(const f32x4*)(bias + (size_t)u.e * bias_stride + col0 + bj * HALF + n * 16) : (f32x4){0.f, 0.f, 0.f, 0.f};
#pragma unroll
        for (int ai = 0; ai < 2; ++ai)
#pragma unroll
            for (int m = 0; m < 4; ++m) { float* rowp = O + (size_t)(row0 + ai * HALF + m * 16) * ldc + col0;
#pragma unroll
                for (int bj = 0; bj < 2; ++bj)
#pragma unroll
                    for (int n = 0; n < 2; ++n) *(f32x4*)(rowp + bj * HALF + n * 16) = acc[ai][bj][m][n] + bv[bj][n]; }
    }
};
struct EpiSwiGLU {
    static constexpr bool PERM = true, AFTER_DRAIN = false;
    bf16_t* O; const float* bias;
    __device__ __forceinline__ float act(float g, float up) const {
        g = fminf(g, SW_LIMIT); up = fminf(fmaxf(up, -SW_LIMIT), SW_LIMIT);
        return (up + 1.0f) * (g * __builtin_amdgcn_rcpf(1.0f + __builtin_amdgcn_exp2f(-SW_ALPHA * LOG2E * g)));
    }
    __device__ __forceinline__ void operator()(const f32x4 (&acc)[2][2][4][2], const Unit& u, int wr, int wc, int fr, int fq) const {
        const int row0 = u.pm * BM + wr * 64 + fr, col0 = u.pn * BM + wc * 32 + 8 * fq;
        f32x4 bv[2][2];
#pragma unroll
        for (int bj = 0; bj < 2; ++bj)
#pragma unroll
            for (int n = 0; n < 2; ++n) bv[bj][n] = *(const f32x4*)(bias + (size_t)u.e * (2 * DFF) + col0 + bj * HALF + 4 * n);
#pragma unroll
        for (int ai = 0; ai < 2; ++ai)
#pragma unroll
            for (int m = 0; m < 4; ++m) { bf16_t* rowp = O + (size_t)(row0 + ai * HALF + m * 16) * DFF + (col0 >> 1);
#pragma unroll
                for (int bj = 0; bj < 2; ++bj) { const f32x4 v0 = acc[ai][bj][m][0] + bv[bj][0], v1 = acc[ai][bj][m][1] + bv[bj][1];
                    u32x2 w; w.x = cvt_pk_bf16(act(v0[0], v0[1]), act(v0[2], v0[3])); w.y = cvt_pk_bf16(act(v1[0], v1[1]), act(v1[2], v1[3]));
                    *(u32x2*)(rowp + bj * (HALF / 2)) = w; } }
    }
};

template <class Epi, class Sched, bool ALIGN_EPI = false, bool SP2 = false>
__device__ __forceinline__ void gemm_phase(PG8_LAS unsigned char* lds, const Gemm g, const Sched& S, const Epi& E) {
    const int tid = otid(), wid = __builtin_amdgcn_readfirstlane(tid >> 6), lane = tid & 63, wr = wid >> 2, wc = wid & 3, fr = lane & 15, fq = lane >> 4;
    const int K = g.K, nt = K / BK;
    unsigned voffA[2], voffB[2];
#pragma unroll
    for (int i = 0; i < 2; ++i) { int R, C; stage_rc(tid * 16 + i * 8192, R, C); const int Rb = Epi::PERM ? ((R & ~31) + perm32(R & 31)) : R;
        voffA[i] = (unsigned)(R * K + C) * 2u; voffB[i] = (unsigned)(Rb * K + C) * 2u; }
    const size_t kstep = (size_t)(BK * 2);
    const size_t hstep = (size_t)HALF * K * 2;
    const size_t tstep = 2 * hstep;
    const unsigned ldsw = (unsigned)wid * 1024u;
    const int aoff = lds_byte(wr * 64 + fr, fq * 8), boff = lds_byte(wc * 32 + fr, fq * 8);
#define PG8_SA(b, h) (((b) * 2 + (h)) * HTB)
#define PG8_SB(b, h) ((4 + (b) * 2 + (h)) * HTB)
#define PG8_STAGE(bufoff, gbase, voff) do { _Pragma("unroll") for (int _i = 0; _i < 2; ++_i) \
        __builtin_amdgcn_global_load_lds((const unsigned*)((const char*)(gbase) + (voff)[_i]), (PG8_LAS unsigned*)(lds + (bufoff) + ldsw + _i * 8192), 16, 0, 0); } while (0)
#define PG8_LDA(dst, b, h) do { _Pragma("unroll") for (int m = 0; m < 4; ++m) _Pragma("unroll") for (int k = 0; k < 2; ++k) dst[m][k] = *(const PG8_LAS bf16x8*)(lds + PG8_SA(b, h) + aoff + m * 2048 + k * 1024); } while (0)
#define PG8_LDB(dst, b, h) do { _Pragma("unroll") for (int n = 0; n < 2; ++n) _Pragma("unroll") for (int k = 0; k < 2; ++k) dst[n][k] = *(const PG8_LAS bf16x8*)(lds + PG8_SB(b, h) + boff + n * 2048 + k * 1024); } while (0)
#define PG8_MMA(ai, bj, At, Bt) do { __builtin_amdgcn_s_setprio(1); _Pragma("unroll") for (int m = 0; m < 4; ++m) _Pragma("unroll") for (int n = 0; n < 2; ++n) _Pragma("unroll") for (int k = 0; k < 2; ++k) \
        acc[ai][bj][m][n] = __builtin_amdgcn_mfma_f32_16x16x32_bf16(Bt[n][k], At[m][k], acc[ai][bj][m][n], 0, 0, 0); __builtin_amdgcn_s_setprio(0); } while (0)
#define PG8_WAIT_V(n) asm volatile("s_waitcnt vmcnt(" #n ")" ::: "memory")
#define PG8_WAIT_L(n) asm volatile("s_waitcnt lgkmcnt(" #n ")" ::: "memory")
#define PG8_BAR __builtin_amdgcn_s_barrier()
#define PG8_SCHED __builtin_amdgcn_sched_barrier(0)
    Unit cur, nxt; int ui = 0;
    if (!S.next(0, cur)) return;
    f32x4 acc[2][2][4][2];
#pragma unroll
    for (int a = 0; a < 2; ++a)
#pragma unroll
        for (int b = 0; b < 2; ++b)
#pragma unroll
            for (int m = 0; m < 4; ++m)
#pragma unroll
                for (int n = 0; n < 2; ++n) acc[a][b][m][n] = (f32x4){0.f, 0.f, 0.f, 0.f};
    bf16x8 At[4][2], B0[2][2], B1[2][2];
    const char* cA = (const char*)g.A + (size_t)cur.pm * tstep; const char* cB = (const char*)g.Bt + (size_t)cur.e * g.bstride + (size_t)cur.pn * tstep;
    S.a_ready(cur);
    if constexpr (SP2) {
        PG8_STAGE(PG8_SB(0, 0), cB, voffB); PG8_STAGE(PG8_SB(0, 1), cB + hstep, voffB); PG8_STAGE(PG8_SA(0, 0), cA, voffA); PG8_STAGE(PG8_SA(0, 1), cA + hstep, voffA);
        if (wr == 1) PG8_BAR;
        PG8_WAIT_V(2); PG8_BAR;
        PG8_STAGE(PG8_SB(1, 0), cB + kstep, voffB); PG8_STAGE(PG8_SA(1, 0), cA + kstep, voffA); PG8_STAGE(PG8_SB(1, 1), cB + hstep + kstep, voffB);
        PG8_WAIT_V(6); PG8_BAR;
    } else {
        PG8_STAGE(PG8_SB(0, 0), cB, voffB); PG8_STAGE(PG8_SA(0, 0), cA, voffA); PG8_STAGE(PG8_SB(0, 1), cB + hstep, voffB); PG8_STAGE(PG8_SA(0, 1), cA + hstep, voffA);
        if (wr == 1) PG8_BAR;
        PG8_WAIT_V(4); PG8_BAR;
        PG8_STAGE(PG8_SB(1, 0), cB + kstep, voffB); PG8_STAGE(PG8_SA(1, 0), cA + kstep, voffA); PG8_STAGE(PG8_SB(1, 1), cB + hstep + kstep, voffB);
        PG8_WAIT_V(6); PG8_BAR;
    }
    for (;;) {
        const bool has_next = S.next(ui + 1, nxt);
        const char* nA = has_next ? (const char*)g.A + (size_t)nxt.pm * tstep : cA; const char* nB = has_next ? (const char*)g.Bt + (size_t)nxt.e * g.bstride + (size_t)nxt.pn * tstep : cB;
        for (int t = 0; t < nt; t += 2) {
            const bool last = (t == nt - 2);
            const char* a1 = cA + (size_t)(t + 1) * kstep;
            const char* a2 = last ? nA : cA + (size_t)(t + 2) * kstep; const char* b2 = last ? nB : cB + (size_t)(t + 2) * kstep;
            const char* a3 = a2 + kstep; const char* b3 = b2 + kstep;
            if (last && has_next) S.a_ready(nxt);
            if constexpr (SP2) {
            PG8_LDB(B0, 0, 0); PG8_LDB(B1, 0, 1); PG8_SCHED; PG8_LDA(At, 0, 0); PG8_STAGE(PG8_SA(1, 1), a1 + hstep, voffA);
            PG8_WAIT_V(8); PG8_WAIT_L(0); PG8_BAR; PG8_MMA(0, 0, At, B0); PG8_MMA(0, 1, At, B1); PG8_BAR; PG8_SCHED;
            PG8_LDA(At, 0, 1); PG8_STAGE(PG8_SB(0, 0), b2, voffB); PG8_STAGE(PG8_SB(0, 1), b2 + hstep, voffB); PG8_STAGE(PG8_SA(0, 0), a2, voffA);
            PG8_WAIT_V(8); PG8_WAIT_L(0); PG8_BAR; PG8_MMA(1, 0, At, B0); PG8_MMA(1, 1, At, B1); PG8_BAR; PG8_SCHED;
            PG8_LDB(B0, 1, 0); PG8_LDB(B1, 1, 1); PG8_SCHED; PG8_LDA(At, 1, 0); PG8_STAGE(PG8_SA(0, 1), a2 + hstep, voffA);
            PG8_WAIT_V(8); PG8_WAIT_L(0); PG8_BAR; PG8_MMA(0, 0, At, B0); PG8_MMA(0, 1, At, B1); PG8_BAR; PG8_SCHED;
            PG8_LDA(At, 1, 1); PG8_STAGE(PG8_SB(1, 0), b3, voffB); PG8_STAGE(PG8_SB(1, 1), b3 + hstep, voffB); PG8_STAGE(PG8_SA(1, 0), a3, voffA);
            PG8_WAIT_V(8); PG8_WAIT_L(0); PG8_BAR; PG8_MMA(1, 0, At, B0); PG8_MMA(1, 1, At, B1); PG8_BAR; PG8_SCHED;
            } else {
            PG8_LDB(B0, 0, 0); PG8_SCHED; PG8_LDA(At, 0, 0); PG8_STAGE(PG8_SA(1, 1), a1 + hstep, voffA);
            PG8_WAIT_L(8); PG8_BAR; PG8_WAIT_L(0); PG8_MMA(0, 0, At, B0); PG8_BAR; PG8_SCHED;
            PG8_LDB(B1, 0, 1); PG8_STAGE(PG8_SB(0, 0), b2, voffB);
            PG8_BAR; PG8_WAIT_L(0); PG8_MMA(0, 1, At, B1); PG8_BAR;
            PG8_LDA(At, 0, 1); PG8_STAGE(PG8_SA(0, 0), a2, voffA);
            PG8_BAR; PG8_WAIT_L(0); PG8_MMA(1, 0, At, B0); PG8_BAR; PG8_SCHED;
            PG8_STAGE(PG8_SB(0, 1), b2 + hstep, voffB);
            PG8_WAIT_V(6); PG8_BAR; PG8_MMA(1, 1, At, B1); PG8_BAR;
            PG8_LDB(B0, 1, 0); PG8_SCHED; PG8_LDA(At, 1, 0); PG8_STAGE(PG8_SA(0, 1), a2 + hstep, voffA);
            PG8_WAIT_L(8); PG8_BAR; PG8_WAIT_L(0); PG8_MMA(0, 0, At, B0); PG8_BAR; PG8_SCHED;
            PG8_LDB(B1, 1, 1); PG8_STAGE(PG8_SB(1, 0), b3, voffB);
            PG8_BAR; PG8_WAIT_L(0); PG8_MMA(0, 1, At, B1); PG8_BAR;
            PG8_LDA(At, 1, 1); PG8_STAGE(PG8_SA(1, 0), a3, voffA);
            PG8_BAR; PG8_WAIT_L(0); PG8_MMA(1, 0, At, B0); PG8_BAR; PG8_SCHED;
            PG8_STAGE(PG8_SB(1, 1), b3 + hstep, voffB);
            PG8_WAIT_V(6); PG8_BAR; PG8_MMA(1, 1, At, B1); PG8_BAR;
            }
        }
        if constexpr (ALIGN_EPI) { if (wr == 0) PG8_BAR; }
        if constexpr (!Epi::AFTER_DRAIN) { E(acc, cur, wr, wc, fr, fq); S.done(cur); }
        if (!has_next) break;
#pragma unroll
        for (int a = 0; a < 2; ++a)
#pragma unroll
            for (int b = 0; b < 2; ++b)
#pragma unroll
                for (int m = 0; m < 4; ++m)
#pragma unroll
                    for (int n = 0; n < 2; ++n) acc[a][b][m][n] = (f32x4){0.f, 0.f, 0.f, 0.f};
        cur = nxt; cA = nA; cB = nB; ++ui;
        if constexpr (ALIGN_EPI) { if (wr == 1) PG8_BAR; }
    }
    PG8_WAIT_V(0);
    if constexpr (!ALIGN_EPI) { if (wr == 0) PG8_BAR; }
    PG8_BAR;
    if constexpr (Epi::AFTER_DRAIN) { E.fused(acc, cur, wr, wc, fr, fq, lds, wid, lane); S.done(cur); }
#undef PG8_SA
#undef PG8_SB
#undef PG8_STAGE
#undef PG8_LDA
#undef PG8_LDB
#undef PG8_MMA
#undef PG8_WAIT_V
#undef PG8_WAIT_L
#undef PG8_BAR
#undef PG8_SCHED
}

}

namespace att {
typedef unsigned short bf16_t;
using bf16x8 = __attribute__((ext_vector_type(8))) short;
using s16x4  = __attribute__((ext_vector_type(4))) short;
using f32x16 = __attribute__((ext_vector_type(16))) float;
using f32x4  = __attribute__((ext_vector_type(4))) float;
using u32x4  = __attribute__((ext_vector_type(4))) unsigned;
#define ATT_LAS __attribute__((address_space(3)))
#define SBAR() __builtin_amdgcn_sched_barrier(0)
constexpr int PITCH = DIN;
constexpr float THR = 8.0f;
constexpr float NEG_BIG = -1e30f;
constexpr int FL_K = 0, FL_KB = 16384, FL_V = 32768, FL_VB = 32768, FL_WS = 98304, FL_Q = 100352;
constexpr int SW_K = 0, SW_V = 49152, SW_VT = 8192;
constexpr int NQR = 1;
constexpr int ATT_LDS = FL_Q + 8 * (8 - NQR) * 1024;

__device__ __forceinline__ int crow(int r, int hi) { return (r & 3) + 8 * (r >> 2) + 4 * hi; }
__device__ __forceinline__ unsigned cvtpk(float lo, float hi) { unsigned r; asm volatile("v_cvt_pk_bf16_f32 %0, %1, %2" : "=v"(r) : "v"(lo), "v"(hi)); return r; }
__device__ __forceinline__ int kswz256(int row, int colB) { return row * 256 + (colB ^ ((row & 7) << 4)); }
__device__ __forceinline__ int kswz128(int row, int colB) { return row * 128 + (colB ^ ((row & 7) << 4)); }
template <int NCB> __device__ __forceinline__ int v_st(int k, int c) { const int kk = (k & ~0xC) | ((k & 4) << 1) | ((k & 8) >> 1); return ((kk >> 3) * NCB + (c >> 5)) * 512 + ((kk & 7) * 32 + (c & 31)) * 2; }
__device__ __forceinline__ int v_rd_base(int lane) { return ((lane & 3) << 3) | (((lane >> 2) & 3) << 6) | (((lane >> 4) & 1) << 5) | (((lane >> 5) & 1) << 8); }
template <int NCB> constexpr int v_rd_off(int d0, int ks, int half) { return d0 * 512 + (2 * ks + half) * NCB * 512; }
template <int OFF> __device__ __forceinline__ s16x4 tr_read(int vb) { s16x4 r; asm volatile("ds_read_b64_tr_b16 %0, %1 offset:%2" : "=&v"(r) : "v"(vb), "i"(OFF) : "memory"); return r; }
template <int NCB, int D0> __device__ __forceinline__ void pv_one(f32x16& od, int vb, bf16x8 pa0, bf16x8 pa1, bf16x8 pa2, bf16x8 pa3) {
    const s16x4 l0 = tr_read<v_rd_off<NCB>(D0, 0, 0)>(vb), h0 = tr_read<v_rd_off<NCB>(D0, 0, 1)>(vb), l1 = tr_read<v_rd_off<NCB>(D0, 1, 0)>(vb), h1 = tr_read<v_rd_off<NCB>(D0, 1, 1)>(vb);
    const s16x4 l2 = tr_read<v_rd_off<NCB>(D0, 2, 0)>(vb), h2 = tr_read<v_rd_off<NCB>(D0, 2, 1)>(vb), l3 = tr_read<v_rd_off<NCB>(D0, 3, 0)>(vb), h3 = tr_read<v_rd_off<NCB>(D0, 3, 1)>(vb);
    asm volatile("s_waitcnt lgkmcnt(0)" ::: "memory"); SBAR();
#define PK(L, H) (bf16x8){L[0], L[1], L[2], L[3], H[0], H[1], H[2], H[3]}
    od = __builtin_amdgcn_mfma_f32_32x32x16_bf16(pa0, PK(l0, h0), od, 0, 0, 0);
    od = __builtin_amdgcn_mfma_f32_32x32x16_bf16(pa1, PK(l1, h1), od, 0, 0, 0);
    od = __builtin_amdgcn_mfma_f32_32x32x16_bf16(pa2, PK(l2, h2), od, 0, 0, 0);
    od = __builtin_amdgcn_mfma_f32_32x32x16_bf16(pa3, PK(l3, h3), od, 0, 0, 0);
#undef PK
}
__device__ __forceinline__ float half_max(float v) { auto rr = __builtin_amdgcn_permlane32_swap(__float_as_uint(v), __float_as_uint(v), false, false); return fmaxf(__uint_as_float(rr[0]), __uint_as_float(rr[1])); }
__device__ __forceinline__ float half_sum(float v) { auto rr = __builtin_amdgcn_permlane32_swap(__float_as_uint(v), __float_as_uint(v), false, false); return __uint_as_float(rr[0]) + __uint_as_float(rr[1]); }
__device__ __forceinline__ float softmax_step(f32x16& p0, f32x16& p1, float& m_reg, float& l_reg) {
    float pmax = p0[0];
#pragma unroll
    for (int r = 1; r < 16; ++r) pmax = fmaxf(pmax, p0[r]);
#pragma unroll
    for (int r = 0; r < 16; ++r) pmax = fmaxf(pmax, p1[r]);
    pmax = half_max(pmax);
    float alpha = 1.f;
    if (!__all(pmax - m_reg <= THR)) { const float mn = fmaxf(m_reg, pmax); alpha = __builtin_amdgcn_exp2f(m_reg - mn); m_reg = mn; }
    float ps = 0.f;
#pragma unroll
    for (int r = 0; r < 16; ++r) { p0[r] = __builtin_amdgcn_exp2f(p0[r] - m_reg); ps += p0[r]; }
#pragma unroll
    for (int r = 0; r < 16; ++r) { p1[r] = __builtin_amdgcn_exp2f(p1[r] - m_reg); ps += p1[r]; }
    ps = half_sum(ps);
    l_reg = l_reg * alpha + ps;
    return alpha;
}
__device__ __forceinline__ void pack_p(const f32x16& p0, const f32x16& p1, bf16x8& pa0, bf16x8& pa1, bf16x8& pa2, bf16x8& pa3) {
#define PK4(P, BASE, OUT) do { unsigned a0 = cvtpk(P[BASE + 0], P[BASE + 1]), a1 = cvtpk(P[BASE + 2], P[BASE + 3]);   \
    unsigned b0 = cvtpk(P[BASE + 4], P[BASE + 5]), b1 = cvtpk(P[BASE + 6], P[BASE + 7]);                              \
    auto r0 = __builtin_amdgcn_permlane32_swap(a0, b0, false, false); auto r1 = __builtin_amdgcn_permlane32_swap(a1, b1, false, false); \
    u32x4 w = {r0[0], r1[0], r0[1], r1[1]}; OUT = __builtin_bit_cast(bf16x8, w); } while (0)
    PK4(p0, 0, pa0); PK4(p0, 8, pa1); PK4(p1, 0, pa2); PK4(p1, 8, pa3);
#undef PK4
}

struct AttnArgs {
    const bf16_t* proj;
    bf16_t* merged;
    float* oscr;
    const float* subln_g;
    const float* sinks;
    float lam, one_m_lam_init;
};

__device__ __forceinline__ float softmax_half(f32x16& p, float& m_reg, float& l_reg) {
    float pmax = p[0];
#pragma unroll
    for (int r = 1; r < 16; ++r) pmax = fmaxf(pmax, p[r]);
    pmax = half_max(pmax);
    float alpha = 1.f;
    if (!__all(pmax - m_reg <= THR)) { const float mn = fmaxf(m_reg, pmax); alpha = __builtin_amdgcn_exp2f(m_reg - mn); m_reg = mn; }
    float ps = 0.f;
#pragma unroll
    for (int r = 0; r < 16; ++r) { p[r] = __builtin_amdgcn_exp2f(p[r] - m_reg); ps += p[r]; }
    ps = half_sum(ps);
    l_reg = l_reg * alpha + ps;
    return alpha;
}
template <int D0, int KS0> __device__ __forceinline__ void pv_half(f32x16& od, int vb, bf16x8 pa0, bf16x8 pa1) {
    const s16x4 l0 = tr_read<v_rd_off<4>(D0, KS0, 0)>(vb), h0 = tr_read<v_rd_off<4>(D0, KS0, 1)>(vb), l1 = tr_read<v_rd_off<4>(D0, KS0 + 1, 0)>(vb), h1 = tr_read<v_rd_off<4>(D0, KS0 + 1, 1)>(vb);
    asm volatile("s_waitcnt lgkmcnt(0)" ::: "memory"); SBAR();
#define PK(L, H) (bf16x8){L[0], L[1], L[2], L[3], H[0], H[1], H[2], H[3]}
    od = __builtin_amdgcn_mfma_f32_32x32x16_bf16(pa0, PK(l0, h0), od, 0, 0, 0);
    od = __builtin_amdgcn_mfma_f32_32x32x16_bf16(pa1, PK(l1, h1), od, 0, 0, 0);
#undef PK
}
template <int HALF_ID> __device__ __forceinline__ void flash_half(f32x16 (&o)[8], const bf16x8 (&qr)[NQR], ATT_LAS const char* qlds, ATT_LAS const char* Ks, int vb, float& m_reg, float& l_reg,
                                                                  float biasbase, float slope2, bool diag, int krel0, int qrel, ATT_LAS float* wsf, int r32, int hi) {
    f32x16 p = f32x16{};
    int kl = kswz256(r32, hi * 16); asm volatile("" : "+v"(kl));
#pragma unroll
    for (int d0 = 0; d0 < 8; ++d0) {
        const bf16x8 b0 = *(ATT_LAS const bf16x8*)(Ks + HALF_ID * 8192 + (kl ^ (d0 * 32)));
        const bf16x8 qf = d0 < NQR ? qr[d0 < NQR ? d0 : 0] : *(ATT_LAS const bf16x8*)(qlds + (d0 - NQR) * 1024);
        p = __builtin_amdgcn_mfma_f32_32x32x16_bf16(b0, qf, p, 0, 0, 0); }
#pragma unroll
    for (int r = 0; r < 16; ++r) p[r] = fmaf(slope2, (float)((r & 3) + 8 * (r >> 2) + 32 * HALF_ID), p[r] + biasbase);
    if (diag) {
#pragma unroll
        for (int r = 0; r < 16; ++r) { const int kr = krel0 + (r & 3) + 8 * (r >> 2) + 32 * HALF_ID; if (kr > qrel) p[r] = -INFINITY; }
    }
    const float alpha = softmax_half(p, m_reg, l_reg);
    if (__any(alpha < 1.f)) {
        if (hi == 0) wsf[r32] = alpha;
        asm volatile("s_waitcnt lgkmcnt(0)" ::: "memory");
#pragma unroll
        for (int g = 0; g < 4; ++g) {
            const f32x4 a4 = *(ATT_LAS const f32x4*)(wsf + 8 * g + 4 * hi);
#pragma unroll
            for (int j = 0; j < 4; ++j)
#pragma unroll
                for (int d = 0; d < 8; ++d) o[d][4 * g + j] *= a4[j];
            asm volatile("" ::: "memory");
        }
    }
    bf16x8 pa0, pa1;
#define PK4(P, BASE, OUT) do { unsigned a0 = cvtpk(P[BASE + 0], P[BASE + 1]), a1 = cvtpk(P[BASE + 2], P[BASE + 3]);   \
    unsigned b0 = cvtpk(P[BASE + 4], P[BASE + 5]), b1 = cvtpk(P[BASE + 6], P[BASE + 7]);                              \
    auto r0 = __builtin_amdgcn_permlane32_swap(a0, b0, false, false); auto r1 = __builtin_amdgcn_permlane32_swap(a1, b1, false, false); \
    u32x4 w = {r0[0], r1[0], r0[1], r1[1]}; OUT = __builtin_bit_cast(bf16x8, w); } while (0)
    PK4(p, 0, pa0); PK4(p, 8, pa1);
#undef PK4
    pv_half<0, 2 * HALF_ID>(o[0], vb, pa0, pa1); pv_half<1, 2 * HALF_ID>(o[1], vb, pa0, pa1); pv_half<2, 2 * HALF_ID>(o[2], vb, pa0, pa1); pv_half<3, 2 * HALF_ID>(o[3], vb, pa0, pa1);
    pv_half<0, 2 * HALF_ID>(o[4], vb + 16384, pa0, pa1); pv_half<1, 2 * HALF_ID>(o[5], vb + 16384, pa0, pa1); pv_half<2, 2 * HALF_ID>(o[6], vb + 16384, pa0, pa1); pv_half<3, 2 * HALF_ID>(o[7], vb + 16384, pa0, pa1);
}
__device__ __forceinline__ void flash_map(f32x16 (&o)[8], const bf16_t* Qw, const bf16_t* Kb, const bf16_t* Vb, int q0, float slope2, ATT_LAS char* lds) {
    const int tid = pg8::otid(), lane = tid & 63, r32 = lane & 31, hi = lane >> 5; const int wid = __builtin_amdgcn_readfirstlane(tid >> 6);
    ATT_LAS float* wsf = (ATT_LAS float*)(lds + FL_WS) + wid * 64;
#pragma unroll
    for (int i = 0; i < 8; ++i) o[i] = f32x16{};
    bf16x8 qr[NQR];
#pragma unroll
    for (int d0 = 0; d0 < NQR; ++d0) qr[d0] = *reinterpret_cast<const bf16x8*>(Qw + d0 * 16);
    ATT_LAS char* qlds = lds + FL_Q + wid * ((8 - NQR) * 1024) + lane * 16;
    float m_reg = NEG_BIG, l_reg = 0.f;
    const int NT = (q0 + 256) / 64;
    const int td = q0 / 64 + (wid >> 1);
    const int qrel = wid * 32 + r32;
#define FL_DMA(t, b) do { int ln_ = lane; asm volatile("" : "+v"(ln_)); const bf16_t* kt = Kb + (size_t)(t) * 64 * PITCH; const bf16_t* vt = Vb + (size_t)(t) * 64 * PITCH; \
        _Pragma("unroll") for (int i_ = 0; i_ < 2; ++i_) { const int row_ = 8 * wid + 4 * i_ + (ln_ >> 4); const unsigned ko_ = (unsigned)(row_ * PITCH + (((ln_ & 15) ^ (row_ & 7)) << 3)); \
            __builtin_amdgcn_global_load_lds((const unsigned*)(kt + ko_), (ATT_LAS unsigned*)(lds + FL_K + (b) * FL_KB + (2 * wid + i_) * 1024), 16, 0, 0); } \
        { const int kk_ = 8 * wid + ((ln_ & 31) >> 2), k_ = (kk_ & ~0xC) | ((kk_ & 4) << 1) | ((kk_ & 8) >> 1); \
          _Pragma("unroll") for (int i_ = 0; i_ < 4; ++i_) { const unsigned vo_ = (unsigned)(k_ * PITCH + 128 * (i_ >> 1) + 32 * (2 * (i_ & 1) + (ln_ >> 5)) + 8 * (ln_ & 3)); \
            __builtin_amdgcn_global_load_lds((const unsigned*)(vt + vo_), (ATT_LAS unsigned*)(lds + FL_V + (b) * FL_VB + (i_ >> 1) * 16384 + (2 * wid + (i_ & 1)) * 1024), 16, 0, 0); } } } while (0)
    const int vrb = (int)(uintptr_t)(lds + FL_V) + v_rd_base(lane);
    __syncthreads();
#pragma unroll
    for (int d0 = 0; d0 < 8 - NQR; ++d0) *(ATT_LAS bf16x8*)(qlds + d0 * 1024) = *reinterpret_cast<const bf16x8*>(Qw + (NQR + d0) * 16);
    FL_DMA(NT - 1, 0);
    asm volatile("s_waitcnt vmcnt(0)" ::: "memory"); __syncthreads();
    for (int it = 0; it < NT; ++it) {
        const int t = NT - 1 - it, buf = it & 1;
        if (t > 0) FL_DMA(t - 1, buf ^ 1);
        {
            ATT_LAS const char* Ks = lds + FL_K + buf * FL_KB; const int vb = vrb + buf * FL_VB;
            const int krel0 = t * 64 - q0 + 4 * hi;
            float s2v = slope2; asm volatile("" : "+v"(s2v));
            const float biasbase = s2v * (float)(krel0 - qrel);
            const bool diag = (t >= td);
            flash_half<1>(o, qr, qlds, Ks, vb, m_reg, l_reg, biasbase, s2v, diag, krel0, qrel, wsf, r32, hi);
            flash_half<0>(o, qr, qlds, Ks, vb, m_reg, l_reg, biasbase, s2v, diag, krel0, qrel, wsf, r32, hi);
        }
        asm volatile("s_waitcnt vmcnt(0)" ::: "memory");
        __syncthreads();
    }
#undef FL_DMA
    if (hi == 0) wsf[32 + r32] = l_reg;
    asm volatile("s_waitcnt lgkmcnt(0)" ::: "memory");
#pragma unroll
    for (int r = 0; r < 16; ++r) { const float rl = 1.0f / wsf[32 + crow(r, hi)];
#pragma unroll
        for (int d = 0; d < 8; ++d) o[d][r] *= rl; }
}

__device__ __forceinline__ void swa_part(const AttnArgs& A, int b, int h, int q0, ATT_LAS char* lds) {
    const int tid = pg8::otid(), lane = tid & 63, r32 = lane & 31, hi = lane >> 5; const int wid = __builtin_amdgcn_readfirstlane(tid >> 6);
    const int kvh = h >> 1;
    const size_t tok0 = (size_t)b * SEQ + q0;
    __syncthreads();
    for (int i = tid; i < 384 * 8; i += 512) {
        const int row = i >> 3, ch = i & 7; const int kpos = q0 - 128 + row;
        bf16x8 kv = bf16x8{}, vv = bf16x8{};
        if (kpos >= 0) { const bf16_t* p = A.proj + ((size_t)b * SEQ + kpos) * PITCH; kv = *reinterpret_cast<const bf16x8*>(p + C_KB + kvh * 64 + ch * 8); vv = *reinterpret_cast<const bf16x8*>(p + C_VB + kvh * 64 + ch * 8); }
        *(ATT_LAS bf16x8*)(lds + SW_K + kswz128(row, ch * 16)) = kv;
        *(ATT_LAS bf16x8*)(lds + SW_V + (row >> 6) * SW_VT + v_st<2>(row & 63, ch * 8)) = vv;
    }
    __syncthreads();
    ATT_LAS float* wsf = (ATT_LAS float*)(lds + FL_WS) + wid * 64;
    const int qrel = wid * 32 + r32;
    const int vrb = (int)(uintptr_t)(lds + SW_V) + v_rd_base(lane);
    for (int hh = 0; hh < 4; ++hh) {
        const int hq = 4 * h + hh;
        const float slope2 = __builtin_amdgcn_exp2f(-0.5f * (float)(hq + 1)) * LOG2E;
        const bf16_t* Qw = A.proj + (tok0 + qrel) * PITCH + C_QB + hq * 64 + hi * 8;
        bf16x8 qr[4];
#pragma unroll
        for (int d0 = 0; d0 < 4; ++d0) qr[d0] = *reinterpret_cast<const bf16x8*>(Qw + d0 * 16);
        float m_reg = A.sinks[hq] * LOG2E, l_reg = 1.0f;
        f32x16 o[2]; o[0] = f32x16{}; o[1] = f32x16{};
        for (int i = 0; i < 3; ++i) {
            const int jt = (wid >> 1) + i;
            f32x16 p0 = f32x16{}, p1 = f32x16{};
            { ATT_LAS const char* Ks = lds + SW_K + jt * 64 * 128;
#pragma unroll
              for (int d0 = 0; d0 < 4; ++d0) { const int cb = (d0 * 16 + hi * 8) * 2;
                  const bf16x8 b0 = *(ATT_LAS const bf16x8*)(Ks + kswz128(r32, cb));
                  const bf16x8 b1 = *(ATT_LAS const bf16x8*)(Ks + kswz128(32 + r32, cb));
                  p0 = __builtin_amdgcn_mfma_f32_32x32x16_bf16(b0, qr[d0], p0, 0, 0, 0);
                  p1 = __builtin_amdgcn_mfma_f32_32x32x16_bf16(b1, qr[d0], p1, 0, 0, 0); } }
            const int krel0 = -128 + 64 * jt + 4 * hi;
#pragma unroll
            for (int r = 0; r < 16; ++r) {
                const int kr = krel0 + (r & 3) + 8 * (r >> 2);
                { const int dist = qrel - kr; const bool ok = (dist >= 0) && (dist < 128) && (q0 + kr >= 0); p0[r] = ok ? p0[r] - slope2 * (float)dist : -INFINITY; }
                { const int dist = qrel - kr - 32; const bool ok = (dist >= 0) && (dist < 128) && (q0 + kr + 32 >= 0); p1[r] = ok ? p1[r] - slope2 * (float)dist : -INFINITY; }
            }
            const float alpha = softmax_step(p0, p1, m_reg, l_reg);
            if (__any(alpha < 1.f)) {
                if (hi == 0) wsf[r32] = alpha;
                asm volatile("s_waitcnt lgkmcnt(0)" ::: "memory");
#pragma unroll
                for (int r = 0; r < 16; ++r) { const float a = wsf[crow(r, hi)]; o[0][r] *= a; o[1][r] *= a; }
            }
            bf16x8 pa0, pa1, pa2, pa3; pack_p(p0, p1, pa0, pa1, pa2, pa3);
            const int vb = vrb + jt * SW_VT;
            pv_one<2, 0>(o[0], vb, pa0, pa1, pa2, pa3); pv_one<2, 1>(o[1], vb, pa0, pa1, pa2, pa3);
        }
        if (hi == 0) wsf[32 + r32] = l_reg;
        asm volatile("s_waitcnt lgkmcnt(0)" ::: "memory");
#pragma unroll
        for (int r = 0; r < 16; ++r) { const int row = wid * 32 + crow(r, hi); const float rl = 1.0f / wsf[32 + crow(r, hi)];
            const bf16_t* gp = A.proj + (tok0 + row) * PITCH + C_GB + hq * 64 + r32; bf16_t* mp = A.merged + (tok0 + row) * DM + hq * 64 + r32;
#pragma unroll
            for (int d = 0; d < 2; ++d) { const float g = __uint_as_float((unsigned)gp[32 * d] << 16); mp[32 * d] = (bf16_t)(cvtpk(o[d][r] * rl * g, 0.f) & 0xffffu); } }
        asm volatile("s_waitcnt lgkmcnt(0)" ::: "memory");
    }
}

__device__ __forceinline__ void attn_unit(const AttnArgs& A, int b, int h, int qb, ATT_LAS char* lds) {
    const int tid = pg8::otid(), lane = tid & 63, r32 = lane & 31, hi = lane >> 5; const int wid = __builtin_amdgcn_readfirstlane(tid >> 6);
    const int q0 = qb * 256; const size_t tok0 = (size_t)b * SEQ + q0;
#ifndef ATT_SKIP
#define ATT_SKIP 0
#endif
    if (!(ATT_SKIP & 1)) swa_part(A, b, h, q0, lds);
    float* park = A.oscr + ((size_t)blockIdx.x * 8 + wid) * (2 * 128 * 64) + lane;
    const float slope2 = __builtin_amdgcn_exp2f(-2.0f * (float)(h + 1)) * LOG2E;
#pragma unroll 1
    for (int c = 0; c < 2; ++c) {
        const bf16_t* Qw = A.proj + (tok0 + wid * 32 + r32) * PITCH + C_QA + h * 256 + c * 128 + hi * 8;
        const bf16_t* Kb = A.proj + (size_t)b * SEQ * PITCH + C_KA + h * 256 + c * 128;
        const bf16_t* Vb = A.proj + (size_t)b * SEQ * PITCH + C_VA + h * 256;
        f32x16 o[8];
        if (!(ATT_SKIP & 2)) flash_map(o, Qw, Kb, Vb, q0, slope2, lds);
        float* pk = park + c * (128 * 64);
#pragma unroll
        for (int d = 0; d < 8; ++d)
#pragma unroll
            for (int r = 0; r < 16; ++r) pk[(d * 16 + r) * 64] = o[d][r];
    }
    if (ATT_SKIP & 4) return;
    float ss[16];
#pragma unroll
    for (int r = 0; r < 16; ++r) { float s = 0.f;
#pragma unroll
        for (int d = 0; d < 8; ++d) { const float v = park[(d * 16 + r) * 64] - A.lam * park[(128 + d * 16 + r) * 64]; s += v * v; }
        ss[r] = s; asm volatile("" ::: "memory"); }
#pragma unroll
    for (int r = 0; r < 16; ++r) {
        float s = ss[r];
        s += __shfl_xor(s, 1); s += __shfl_xor(s, 2); s += __shfl_xor(s, 4); s += __shfl_xor(s, 8); s += __shfl_xor(s, 16);
        ss[r] = 1.0f / sqrtf(s * (1.0f / 256.0f) + LN_EPS);
    }
    float gsub[8];
#pragma unroll
    for (int d = 0; d < 8; ++d) gsub[d] = A.subln_g[32 * d + r32] * A.one_m_lam_init;
#pragma unroll
    for (int r = 0; r < 16; ++r) { const int row = wid * 32 + crow(r, hi);
        const bf16_t* gp = A.proj + (tok0 + row) * PITCH + C_GA + h * 256 + r32; bf16_t* mp = A.merged + (tok0 + row) * DM + h * 256 + r32;
#pragma unroll
        for (int d = 0; d < 8; ++d) { const float v = park[(d * 16 + r) * 64] - A.lam * park[(128 + d * 16 + r) * 64];
            const float g = __uint_as_float((unsigned)gp[32 * d] << 16); const float sw = __uint_as_float((unsigned)mp[32 * d] << 16);
            mp[32 * d] = (bf16_t)(cvtpk(v * ss[r] * gsub[d] * g + sw, 0.f) & 0xffffu); }
        asm volatile("" ::: "memory"); }
}
#undef SBAR
}

constexpr int NWAVES = 8;
constexpr int NPHASE = 1 + 8 * DEPTH;
constexpr size_t MiB = 1u << 20;
constexpr size_t al_mib(size_t x) { return (x + MiB - 1) / MiB * MiB; }
constexpr size_t WS_CTL  = 0,                         CTL_ZERO_BYTES = 1 * MiB;
constexpr size_t WS_WIN  = WS_CTL + CTL_ZERO_BYTES,   SZ_WIN  = al_mib((size_t)DEPTH * DIN * DM * 2);
constexpr size_t WS_WO   = WS_WIN + SZ_WIN,           SZ_WO   = al_mib((size_t)DEPTH * DM * DM * 2);
constexpr size_t WS_WUP  = WS_WO + SZ_WO,             SZ_WUP  = al_mib((size_t)DEPTH * NEXP * 2 * DFF * DM * 2);
constexpr size_t WS_WDN  = WS_WUP + SZ_WUP,           SZ_WDN  = al_mib((size_t)DEPTH * NEXP * DM * DFF * 2);
constexpr size_t WS_XB   = WS_WDN + SZ_WDN,           SZ_XB   = al_mib((size_t)TOK * DM * 2);
constexpr size_t WS_XF   = WS_XB + SZ_XB,             SZ_XF   = al_mib((size_t)TOK * DM * 4);
constexpr size_t WS_PROJ = WS_XF + SZ_XF,             SZ_PROJ = al_mib((size_t)TOK * DIN * 2);
constexpr size_t WS_MRG  = WS_PROJ + SZ_PROJ,         SZ_MRG  = al_mib((size_t)TOK * DM * 2);
constexpr size_t WS_MIX  = WS_MRG + SZ_MRG,           SZ_MIX  = al_mib((size_t)TOK * DM * 4);
constexpr size_t WS_HF   = WS_MIX + SZ_MIX,           SZ_HF   = al_mib((size_t)TOK * DM * 4);
constexpr size_t WS_HB   = WS_HF + SZ_HF,             SZ_HB   = al_mib((size_t)TOK * DM * 2);
constexpr size_t WS_EID  = WS_HB + SZ_HB,             SZ_EID  = al_mib((size_t)TK * 4);
constexpr size_t WS_GATE = WS_EID + SZ_EID,           SZ_GATE = al_mib((size_t)TK * 4);
constexpr size_t WS_DEST = WS_GATE + SZ_GATE,         SZ_DEST = al_mib((size_t)TK * 4);
constexpr size_t WS_CNT  = WS_DEST + SZ_DEST,         SZ_CNT  = MiB;
constexpr size_t WS_XG   = WS_CNT + SZ_CNT,           SZ_XG   = al_mib((size_t)MAXBLK * 256 * DM * 2);
constexpr size_t WS_ACT  = WS_XG + SZ_XG,             SZ_ACT  = al_mib((size_t)MAXBLK * 256 * DFF * 2);
constexpr size_t WS_Y    = WS_ACT + SZ_ACT,           SZ_Y    = al_mib((size_t)MAXBLK * 256 * DM * 4);
constexpr size_t WS_OSCR = WS_Y + SZ_Y,               SZ_OSCR = al_mib((size_t)256 * 8 * 2 * 128 * 64 * 4);
constexpr size_t WS_END  = WS_OSCR + SZ_OSCR;
constexpr int NCHUNK = TOK / 128;
constexpr int CNT_BLKE = NCHUNK * NEXP, CNT_NBLK = CNT_BLKE + MAXBLK;
constexpr int CW_BAR = 4096;
constexpr int RING_OFF = 0, RING_BYTES = 158720;
constexpr int LDSCTL_OFF = RING_BYTES, MISC_OFF = LDSCTL_OFF + 320;
constexpr int LDS_BYTES = 163840;
static_assert(att::ATT_LDS <= RING_BYTES, "attention LDS");

#define GAS __attribute__((address_space(1)))
#define LAS __attribute__((address_space(3)))
typedef unsigned short bf16;
typedef unsigned v4u __attribute__((ext_vector_type(4)));
typedef float f32x4 __attribute__((ext_vector_type(4)));
typedef short bf16x8 __attribute__((ext_vector_type(8)));
typedef GAS unsigned gu32;
typedef GAS unsigned long long gu64;
#define RLX_AGENT __ATOMIC_RELAXED, __HIP_MEMORY_SCOPE_AGENT
#define LDS_WAIT() asm volatile("s_waitcnt lgkmcnt(0)" ::: "memory")
#define VM_WAIT() asm volatile("s_waitcnt vmcnt(0)" ::: "memory")
__device__ __forceinline__ unsigned long long rt() { return __builtin_amdgcn_s_memrealtime(); }
__device__ __forceinline__ unsigned f2bf(float f) { unsigned u = __builtin_bit_cast(unsigned, f); return (u + 0x7fffu + ((u >> 16) & 1u)) >> 16; }
__device__ __forceinline__ unsigned pk2(float lo, float hi) { return f2bf(lo) | (f2bf(hi) << 16); }
#define XB_TMO      128
#define XB_XCNT(j)  (256  + 64 * (j))
#define XB_XSUB(j)  (1280 + 64 * (j))
#define XB_XGEN(j)  (2304 + 64 * (j))
#define XB_TOP      3328
#define XB_TOPGEN   3392
#define XCD_BAR_WORDS 3456
#define XB_SPIN_CAP (1u << 18)

__device__ __forceinline__ unsigned xb_ld(unsigned* p)              { return __hip_atomic_load(p, __ATOMIC_RELAXED, __HIP_MEMORY_SCOPE_AGENT); }
__device__ __forceinline__ unsigned xb_add(unsigned* p, unsigned v) { return __hip_atomic_fetch_add(p, v, __ATOMIC_RELAXED, __HIP_MEMORY_SCOPE_AGENT); }
__device__ __forceinline__ unsigned xb_xcc_id() { return (unsigned)__builtin_amdgcn_s_getreg((3 << 11) | 20) & 0xFu; }
#define XB_SPIN(cond, bar) do { unsigned _sp = 0; while (cond) { __builtin_amdgcn_s_sleep(1); \
    if ((++_sp & 255u) == 0u) { if (xb_ld(&(bar)[XB_TMO])) break; if (_sp > XB_SPIN_CAP) { atomicAdd(&(bar)[XB_TMO], 1u); break; } } } } while (0)

struct XcdBarrier {
    unsigned* bar; unsigned x;
    volatile LAS unsigned* st;
};

__device__ __forceinline__ XcdBarrier xcd_barrier_post(unsigned* bar, volatile LAS unsigned* st) {
    XcdBarrier b; b.bar = bar; b.x = xb_xcc_id(); b.st = st;
    if (threadIdx.x == 0) (void)xb_add(&bar[XB_XCNT(b.x)], 1u);
    return b;
}
__device__ __forceinline__ void xcd_barrier_complete(unsigned* bar, unsigned x, unsigned& nloc, unsigned& nx) {
    const unsigned G = gridDim.x * gridDim.y * gridDim.z;
    unsigned sum, cnt, mine, sp = 0u;
    for (;;) {
        sum = 0u; cnt = 0u; mine = 0u;
#pragma unroll
        for (unsigned j = 0; j < 16; ++j) { const unsigned c = xb_ld(&bar[XB_XCNT(j)]); sum += c; cnt += (c > 0u) ? 1u : 0u; mine = (j == x) ? c : mine; }
        if (sum == G) break;
        __builtin_amdgcn_s_sleep(1);
        if ((++sp & 255u) == 0u) { if (xb_ld(&bar[XB_TMO])) break; if (sp > XB_SPIN_CAP) { atomicAdd(&bar[XB_TMO], 1u); break; } }
    }
    nloc = mine > 0u ? mine : 1u; nx = cnt > 0u ? cnt : 1u;
}

__device__ __forceinline__ void xcd_barrier(const XcdBarrier& b) {
    asm volatile("s_waitcnt vmcnt(0)" ::: "memory");
    __syncthreads();
    if (threadIdx.x == 0) {
        unsigned* bar = b.bar;
        __builtin_amdgcn_s_waitcnt(0);
        unsigned nloc = b.st[0], nx = b.st[1];
        if (nloc == 0u) { xcd_barrier_complete(bar, b.x, nloc, nx); b.st[0] = nloc; b.st[1] = nx; }
        const unsigned old = xb_add(&bar[XB_XSUB(b.x)], 1u);
        const unsigned gen = old / nloc;
        if (old + 1u == (gen + 1u) * nloc) {
            __builtin_amdgcn_fence(__ATOMIC_RELEASE, "agent");
            asm volatile("s_waitcnt vmcnt(0)" ::: "memory");
            const unsigned og = xb_add(&bar[XB_TOP], 1u);
            const unsigned tg = og / nx;
            if (og + 1u == (tg + 1u) * nx) xb_add(&bar[XB_TOPGEN], 1u);
            else XB_SPIN(xb_ld(&bar[XB_TOPGEN]) == tg, bar);
            __builtin_amdgcn_fence(__ATOMIC_ACQUIRE, "agent");
            xb_add(&bar[XB_XGEN(b.x)], 1u);
            asm volatile("s_waitcnt vmcnt(0)" ::: "memory");
        } else {
            XB_SPIN(xb_ld(&bar[XB_XGEN(b.x)]) == gen, bar);
            __builtin_amdgcn_fence(__ATOMIC_ACQUIRE, "agent");
            asm volatile("s_waitcnt vmcnt(0)" ::: "memory");
        }
    }
    __syncthreads();
}


__device__ __forceinline__ float wave_sum(float v) {
#pragma unroll
    for (int o = 1; o < 64; o <<= 1) v += __shfl_xor(v, o);
    return v;
}
__device__ __forceinline__ void p0_transpose_item(const float* W, int K, int N, bf16* WT, LAS float* scr, int item, int lane) {
    const int nblk = N / 32, kb = item / nblk, nb = item % nblk, k0 = 64 * kb, n0 = 32 * nb;
#pragma unroll 8
    for (int i = 0; i < 32; ++i) { const int kk = 2 * i + (lane >> 5); scr[kk * 33 + (lane & 31)] = W[(size_t)(k0 + kk) * N + n0 + (lane & 31)]; }
    LDS_WAIT(); asm volatile("" ::: "memory");
    const int c = lane & 7;
#pragma unroll
    for (int j = 0; j < 4; ++j) { const int n = (lane >> 3) + 8 * j; const LAS float* s = scr + (8 * c) * 33 + n;
        v4u o; o.x = pk2(s[0 * 33], s[1 * 33]); o.y = pk2(s[2 * 33], s[3 * 33]); o.z = pk2(s[4 * 33], s[5 * 33]); o.w = pk2(s[6 * 33], s[7 * 33]);
        *(GAS v4u*)(WT + (size_t)(n0 + n) * K + k0 + 8 * c) = o; }
    LDS_WAIT(); asm volatile("" ::: "memory");
}

struct Args { const float* in[14]; float* out; unsigned char* ws; int g_lo, g_hi; };

__global__ void __launch_bounds__(NWAVES * 64, 2) mk_fwd(Args args) {
    extern __shared__ __attribute__((aligned(16))) unsigned char lds_raw[];
    LAS unsigned char* lds = (LAS unsigned char*)lds_raw;
    volatile LAS unsigned* MISC = (volatile LAS unsigned*)(lds + MISC_OFF);
    const int tid0 = threadIdx.x;
    const int G = gridDim.x; const int vcu = (G % 8 == 0) ? ((int)blockIdx.x % 8) * (G / 8) + (int)blockIdx.x / 8 : (int)blockIdx.x;
    gu32* ctl = (gu32*)(args.ws + WS_CTL);
    for (int u = tid0; u < (LDS_BYTES - LDSCTL_OFF) / 4; u += NWAVES * 64) ((LAS unsigned*)(lds + LDSCTL_OFF))[u] = 0u;
    __syncthreads();
    XcdBarrier bar; bar.bar = (unsigned*)(ctl + CW_BAR); bar.x = 0; bar.st = nullptr;
    if (MK_SINGLE) bar = xcd_barrier_post((unsigned*)(ctl + CW_BAR), MISC + 8);
    const int g_lo = args.g_lo, g_hi = args.g_hi;
#ifndef PH_EN
#define PH_EN 0x1ff
#endif
#define IN(k) (g_lo <= (k) && (k) < g_hi)
#define BAR_IF(k) do { if (MK_SINGLE && IN(k)) xcd_barrier(bar); } while (0)

#define PHASE_BEGIN() unsigned char* ws = args.ws; asm volatile("" : "+s"(ws)); const int tid = pg8::otid(), lane = tid & 63, wave = __builtin_amdgcn_readfirstlane(tid >> 6); \
    const int gw = vcu * NWAVES + wave, NGW = G * NWAVES; (void)lane; (void)gw; (void)NGW; \
    bf16* WIN_t = (bf16*)(ws + WS_WIN); bf16* WO_t = (bf16*)(ws + WS_WO); bf16* WUP_t = (bf16*)(ws + WS_WUP); bf16* WDN_t = (bf16*)(ws + WS_WDN); \
    bf16* XB = (bf16*)(ws + WS_XB); float* XF = (float*)(ws + WS_XF); bf16* PROJ = (bf16*)(ws + WS_PROJ); bf16* MRG = (bf16*)(ws + WS_MRG); \
    float* MIX = (float*)(ws + WS_MIX); float* HF = (float*)(ws + WS_HF); bf16* HB = (bf16*)(ws + WS_HB); \
    int* EID = (int*)(ws + WS_EID); float* GATE = (float*)(ws + WS_GATE); int* DEST = (int*)(ws + WS_DEST); int* CNT = (int*)(ws + WS_CNT); \
    bf16* XG = (bf16*)(ws + WS_XG); bf16* ACT = (bf16*)(ws + WS_ACT); float* Y = (float*)(ws + WS_Y); float* OSCR = (float*)(ws + WS_OSCR); \
    (void)WIN_t; (void)WO_t; (void)WUP_t; (void)WDN_t; (void)XB; (void)XF; (void)PROJ; (void)MRG; (void)MIX; (void)HF; (void)HB; (void)EID; (void)GATE; (void)DEST; (void)CNT; (void)XG; (void)ACT; (void)Y; (void)OSCR

    if ((PH_EN & 1) && IN(0)) {
        PHASE_BEGIN();
        LAS float* scr = (LAS float*)(lds + RING_OFF + wave * 16384);
        constexpr int I_IN = 16 * (DIN / 32), I_O = 16 * (DM / 32), I_UP = 16 * (2 * DFF / 32), I_DN = 16 * (DM / 32);
        constexpr int I_LAYER = I_IN + I_O + NEXP * I_UP + NEXP * I_DN, NITEMS = DEPTH * I_LAYER;
        for (int it = gw; it < NITEMS; it += NGW) {
            const int l = it / I_LAYER; int r = it % I_LAYER;
            if (r < I_IN) { p0_transpose_item(args.in[1] + (size_t)l * DM * DIN, DM, DIN, WIN_t + (size_t)l * DIN * DM, scr, r, lane); continue; } r -= I_IN;
            if (r < I_O) { p0_transpose_item(args.in[2] + (size_t)l * DM * DM, DM, DM, WO_t + (size_t)l * DM * DM, scr, r, lane); continue; } r -= I_O;
            if (r < NEXP * I_UP) { const int e = r / I_UP; p0_transpose_item(args.in[10] + ((size_t)l * NEXP + e) * DM * 2 * DFF, DM, 2 * DFF, WUP_t + ((size_t)l * NEXP + e) * 2 * DFF * DM, scr, r % I_UP, lane); continue; } r -= NEXP * I_UP;
            { const int e = r / I_DN; p0_transpose_item(args.in[12] + ((size_t)l * NEXP + e) * DFF * DM, DFF, DM, WDN_t + ((size_t)l * NEXP + e) * DM * DFF, scr, r % I_DN, lane); }
        }
        for (int m = gw; m < TOK; m += NGW) {
            const GAS f32x4* xr = (const GAS f32x4*)(args.in[0] + (size_t)m * DM) + lane; GAS unsigned long long* o8 = (GAS unsigned long long*)(XB + (size_t)m * DM) + lane;
#pragma unroll
            for (int j = 0; j < 4; ++j) { const f32x4 v = xr[64 * j]; o8[64 * j] = (unsigned long long)pk2(v.x, v.y) | ((unsigned long long)pk2(v.z, v.w) << 32); }
        }
        BAR_IF(1);
    }

    for (int l = 0; l < DEPTH; ++l) {
        const int pb = 1 + 8 * l;
        if ((PH_EN & 2) && IN(pb + 0)) {
            PHASE_BEGIN();
            pg8::Gemm g{XB, WIN_t + (size_t)l * DIN * DM, TOK, DIN, DM, 0}; pg8::StaticOrder S; S.init(TOK, DIN, G, (int)blockIdx.x, nullptr);
            pg8::EpiInProj E{PROJ};
            pg8::gemm_phase<pg8::EpiInProj, pg8::StaticOrder, true, true>(lds + RING_OFF, g, S, E);
            BAR_IF(pb + 1);
        }
        if ((PH_EN & 4) && IN(pb + 1)) {
            PHASE_BEGIN();
            const float* lq = args.in[3] + (size_t)l * 4 * 128;
            float d1 = 0.f, d2 = 0.f;
            for (int i = 0; i < 128; ++i) { d1 += lq[i] * lq[128 + i]; d2 += lq[256 + i] * lq[384 + i]; }
            const float lam_init = 0.8f - 0.6f * expf(-0.3f * (float)l);
            att::AttnArgs A; A.proj = PROJ; A.merged = MRG; A.oscr = OSCR; { const float* sg_ = args.in[4] + (size_t)l * 256; const float* sk_ = args.in[5] + (size_t)l * 16; asm volatile("" : "+s"(sg_), "+s"(sk_)); A.subln_g = sg_; A.sinks = sk_; }
            A.lam = expf(d1) - expf(d2) + lam_init; A.one_m_lam_init = 1.0f - lam_init;
            for (int pi = vcu; pi < 256; pi += G) {
                const int bh = pi >> 5, s = pi & 31;
                att::attn_unit(A, bh >> 2, bh & 3, 63 - s, (ATT_LAS char*)(lds + RING_OFF));
                att::attn_unit(A, bh >> 2, bh & 3, s, (ATT_LAS char*)(lds + RING_OFF));
            }
            __syncthreads();
            BAR_IF(pb + 2);
        }
        if ((PH_EN & 8) && IN(pb + 2)) {
            PHASE_BEGIN();
            pg8::Gemm g{MRG, WO_t + (size_t)l * DM * DM, TOK, DM, DM, 0}; pg8::StaticOrder S; S.init(TOK, DM, G, (int)blockIdx.x, nullptr);
            pg8::EpiF32 E{MIX, DM, nullptr, 0};
            pg8::gemm_phase<pg8::EpiF32, pg8::StaticOrder, true, true>(lds + RING_OFF, g, S, E);
            BAR_IF(pb + 3);
        }
        if ((PH_EN & 16) && IN(pb + 3)) {
            PHASE_BEGIN();
            const float* xin = (l == 0) ? args.in[0] : XF;
            const float* lg_ = args.in[6] + (size_t)(l * 2 + 0) * DM; const float* lb_ = args.in[7] + (size_t)(l * 2 + 0) * DM;
            const float* WR = args.in[8] + (size_t)l * DM * NEXP; const float* BR = args.in[9] + (size_t)l * NEXP;
            LAS int* lcnt = (LAS int*)(lds + RING_OFF);
            for (int chunk = blockIdx.x; chunk < NCHUNK; chunk += G) {
                if (tid < NEXP) lcnt[tid] = 0;
                f32x4 gv[4], bv[4];
#pragma unroll
                for (int j = 0; j < 4; ++j) { gv[j] = *((const f32x4*)lg_ + lane + 64 * j); bv[j] = *((const f32x4*)lb_ + lane + 64 * j); }
                for (int i = 0; i < 16; ++i) {
                    const size_t row = (size_t)chunk * 128 + wave * 16 + i;
                    const f32x4* xr = (const f32x4*)(xin + row * DM) + lane; const f32x4* mr = (const f32x4*)(MIX + row * DM) + lane;
                    f32x4 v[4]; float s = 0.f;
#pragma unroll
                    for (int j = 0; j < 4; ++j) { v[j] = xr[64 * j] * DN_ALPHA + mr[64 * j]; s += (v[j].x + v[j].y) + (v[j].z + v[j].w); }
                    const float mean = wave_sum(s) * (1.f / DM); float s2 = 0.f;
#pragma unroll
                    for (int j = 0; j < 4; ++j) { v[j] = v[j] - mean; s2 += (v[j].x * v[j].x + v[j].y * v[j].y) + (v[j].z * v[j].z + v[j].w * v[j].w); }
                    const float rstd = 1.f / sqrtf(wave_sum(s2) * (1.f / DM) + LN_EPS);
                    f32x4* hr = (f32x4*)(HF + row * DM) + lane; unsigned long long* hb8 = (unsigned long long*)(HB + row * DM) + lane;
#pragma unroll
                    for (int j = 0; j < 4; ++j) { const f32x4 hv = v[j] * rstd * gv[j] + bv[j]; hr[64 * j] = hv; hb8[64 * j] = (unsigned long long)pk2(hv.x, hv.y) | ((unsigned long long)pk2(hv.z, hv.w) << 32); }
                }
                VM_WAIT(); __syncthreads();
                if (wave < 4) {
                    const int r32 = lane & 31, hi = lane >> 5; const size_t t0 = (size_t)chunk * 128 + wave * 32;
                    att::f32x16 acc = att::f32x16{};
                    const float* hrow = HF + (t0 + r32) * DM + 4 * hi; const float* wrp = WR + (size_t)(4 * hi) * NEXP + r32;
#pragma unroll 2
                    for (int u = 0; u < 128; ++u) {
                        const f32x4 hv = *(const f32x4*)(hrow + 8 * u);
#pragma unroll
                        for (int j = 0; j < 4; ++j) { const float a = wrp[(size_t)(8 * u + j) * NEXP]; acc = __builtin_amdgcn_mfma_f32_32x32x2f32(a, hv[j], acc, 0, 0, 0); }
                    }
                    float lg[32];
#pragma unroll
                    for (int r = 0; r < 16; ++r) { const float mine = acc[r], other = __shfl_xor(mine, 32); const int e0 = (r & 3) + 8 * (r >> 2), e1 = e0 + 4;
                        lg[e0] = hi ? other : mine; lg[e1] = hi ? mine : other; }
#pragma unroll
                    for (int e = 0; e < 32; ++e) lg[e] += BR[e];
                    int ei[4]; float ev[4];
#pragma unroll
                    for (int k = 0; k < 4; ++k) { float best = -INFINITY; int bi = 0;
#pragma unroll
                        for (int e = 0; e < 32; ++e) if (lg[e] > best) { best = lg[e]; bi = e; }
                        ev[k] = best; ei[k] = bi;
#pragma unroll
                        for (int e = 0; e < 32; ++e) lg[e] = (e == bi) ? -INFINITY : lg[e]; }
                    float w[4], wsum = 0.f;
#pragma unroll
                    for (int k = 0; k < 4; ++k) { w[k] = __builtin_amdgcn_exp2f((ev[k] - ev[0]) * LOG2E); wsum += w[k]; }
                    const float rs = 1.0f / wsum;
                    if (hi == 0) {
                        typedef int i32x4 __attribute__((ext_vector_type(4)));
                        *(i32x4*)(EID + (t0 + r32) * 4) = (i32x4){ei[0], ei[1], ei[2], ei[3]};
                        *(f32x4*)(GATE + (t0 + r32) * 4) = (f32x4){w[0] * rs, w[1] * rs, w[2] * rs, w[3] * rs};
#pragma unroll
                        for (int k = 0; k < 4; ++k) __hip_atomic_fetch_add(lcnt + ei[k], 1, __ATOMIC_RELAXED, __HIP_MEMORY_SCOPE_WORKGROUP);
                    }
                }
                __syncthreads();
                if (tid < NEXP) CNT[chunk * NEXP + tid] = lcnt[tid];
                __syncthreads();
            }
            BAR_IF(pb + 4);
        }
        if ((PH_EN & 32) && IN(pb + 4)) {
            PHASE_BEGIN();
            LAS int* stot = (LAS int*)(lds + RING_OFF); LAS int* spre = stot + 512; LAS int* ltot = spre + 512; LAS int* lpre = ltot + 32; LAS int* lstart = lpre + 32;
            LAS int* lbase = lstart + 32; LAS int* lnb = lbase + 32; LAS int* ldest = lnb + 32;
            for (int chunk = blockIdx.x; chunk < NCHUNK; chunk += G) {
                { const int e = tid & 31, part = tid >> 5; int tot = 0, pre = 0;
                  for (int c = part * 16; c < part * 16 + 16; ++c) { const int v = CNT[c * NEXP + e]; tot += v; pre += (c < chunk) ? v : 0; }
                  stot[part * 32 + e] = tot; spre[part * 32 + e] = pre; }
                __syncthreads();
                if (tid < 32) { int tot = 0, pre = 0; for (int p = 0; p < 16; ++p) { tot += stot[p * 32 + tid]; pre += spre[p * 32 + tid]; } ltot[tid] = tot; lpre[tid] = pre; }
                __syncthreads();
                if (tid == 0) { int a = 0; for (int e = 0; e < 32; ++e) { lstart[e] = a; a += (ltot[e] + 255) & ~255; } lnb[0] = a >> 8; }
                __syncthreads();
                if (tid < 32) lbase[tid] = lstart[tid] + lpre[tid];
                if (chunk == 0) {
                    for (int blk = tid; blk < MAXBLK; blk += 512) { int e = 31; for (int q = 31; q >= 0; --q) if (blk * 256 < lstart[q] + ((ltot[q] + 255) & ~255)) e = q; CNT[CNT_BLKE + blk] = e; }
                    if (tid == 0) CNT[CNT_NBLK] = lnb[0];
                }
                __syncthreads();
                { const size_t t = (size_t)chunk * 128 + (tid >> 2); const int k = tid & 3; const int e = EID[t * 4 + k];
                  const int pos = __hip_atomic_fetch_add(lbase + e, 1, __ATOMIC_RELAXED, __HIP_MEMORY_SCOPE_WORKGROUP); DEST[t * 4 + k] = pos; ldest[tid] = pos; }
                __syncthreads();
                for (int p = 0; p < 64; ++p) { const int pair = wave * 64 + p; const size_t t = (size_t)chunk * 128 + (pair >> 2); const int pos = ldest[pair];
                    const v4u* src = (const v4u*)(HB + t * DM) + lane; v4u* dst = (v4u*)(XG + (size_t)pos * DM) + lane; dst[0] = src[0]; dst[64] = src[64]; }
                if (chunk < NEXP) { const int e = chunk; const int r0 = lstart[e] + ltot[e], r1 = lstart[e] + ((ltot[e] + 255) & ~255);
                    for (int i = tid; i < (r1 - r0) * 128; i += 512) ((v4u*)(XG + (size_t)r0 * DM))[i] = (v4u){0u, 0u, 0u, 0u}; }
                __syncthreads();
            }
            BAR_IF(pb + 5);
        }
        if ((PH_EN & 64) && IN(pb + 5)) {
            PHASE_BEGIN();
            const int nblk = __builtin_amdgcn_readfirstlane(__hip_atomic_load(CNT + CNT_NBLK, RLX_AGENT));
            pg8::Gemm g{XG, WUP_t + (size_t)l * NEXP * 2 * DFF * DM, nblk * 256, 2 * DFF, DM, (size_t)2 * DFF * DM * 2}; pg8::StaticOrder S; S.init(nblk * 256, 2 * DFF, G, (int)blockIdx.x, CNT + CNT_BLKE);
            pg8::EpiSwiGLU E{ACT, args.in[11] + (size_t)l * NEXP * 2 * DFF};
            pg8::gemm_phase<pg8::EpiSwiGLU, pg8::StaticOrder, true, true>(lds + RING_OFF, g, S, E);
            BAR_IF(pb + 6);
        }
        if ((PH_EN & 128) && IN(pb + 6)) {
            PHASE_BEGIN();
            const int nblk = __builtin_amdgcn_readfirstlane(__hip_atomic_load(CNT + CNT_NBLK, RLX_AGENT));
            pg8::Gemm g{ACT, WDN_t + (size_t)l * NEXP * DM * DFF, nblk * 256, DM, DFF, (size_t)DM * DFF * 2}; pg8::StaticOrder S; S.init(nblk * 256, DM, G, (int)blockIdx.x, CNT + CNT_BLKE);
            pg8::EpiF32 E{Y, DM, args.in[13] + (size_t)l * NEXP * DM, DM};
            pg8::gemm_phase<pg8::EpiF32, pg8::StaticOrder, true, true>(lds + RING_OFF, g, S, E);
            BAR_IF(pb + 7);
        }
        if ((PH_EN & 256) && IN(pb + 7)) {
            PHASE_BEGIN();
            const float* lg_ = args.in[6] + (size_t)(l * 2 + 1) * DM; const float* lb_ = args.in[7] + (size_t)(l * 2 + 1) * DM;
            float* xo = (l == DEPTH - 1) ? args.out : XF;
            f32x4 gv[4], bv[4];
#pragma unroll
            for (int j = 0; j < 4; ++j) { gv[j] = *((const f32x4*)lg_ + lane + 64 * j); bv[j] = *((const f32x4*)lb_ + lane + 64 * j); }
            for (int m = gw; m < TOK; m += NGW) {
                typedef int i32x4 __attribute__((ext_vector_type(4)));
                const i32x4 dd = *(const i32x4*)(DEST + (size_t)m * 4); const f32x4 gg = *(const f32x4*)(GATE + (size_t)m * 4);
                const f32x4* hr = (const f32x4*)(HF + (size_t)m * DM) + lane;
                const f32x4* y0 = (const f32x4*)(Y + (size_t)dd.x * DM) + lane; const f32x4* y1 = (const f32x4*)(Y + (size_t)dd.y * DM) + lane;
                const f32x4* y2 = (const f32x4*)(Y + (size_t)dd.z * DM) + lane; const f32x4* y3 = (const f32x4*)(Y + (size_t)dd.w * DM) + lane;
                f32x4 v[4]; float s = 0.f;
#pragma unroll
                for (int j = 0; j < 4; ++j) { v[j] = hr[64 * j] * DN_ALPHA + (y0[64 * j] * gg.x + y1[64 * j] * gg.y + y2[64 * j] * gg.z + y3[64 * j] * gg.w); s += (v[j].x + v[j].y) + (v[j].z + v[j].w); }
                const float mean = wave_sum(s) * (1.f / DM); float s2 = 0.f;
#pragma unroll
                for (int j = 0; j < 4; ++j) { v[j] = v[j] - mean; s2 += (v[j].x * v[j].x + v[j].y * v[j].y) + (v[j].z * v[j].z + v[j].w * v[j].w); }
                const float rstd = 1.f / sqrtf(wave_sum(s2) * (1.f / DM) + LN_EPS);
                f32x4* xr = (f32x4*)(xo + (size_t)m * DM) + lane; unsigned long long* xb8 = (unsigned long long*)(XB + (size_t)m * DM) + lane;
#pragma unroll
                for (int j = 0; j < 4; ++j) { const f32x4 o = v[j] * rstd * gv[j] + bv[j]; xr[64 * j] = o; xb8[64 * j] = (unsigned long long)pk2(o.x, o.y) | ((unsigned long long)pk2(o.z, o.w) << 32); }
            }
            BAR_IF(pb + 8);
        }
    }
#undef IN
#undef BAR_IF
}

extern "C" void kernel_launch(void* const* d_in, const int* in_sizes, int n_in, void* d_out, int out_size, void* d_ws, size_t ws_size, hipStream_t stream) {
    static int grid = 0;
    if (grid == 0) {
        if (n_in != 14 || in_sizes[0] != TOK * DM || out_size != TOK * DM || ws_size < WS_END) { fprintf(stderr, "kernel_launch: shape/workspace mismatch (n_in %d, in0 %d, out %d, ws %zu, need %zu)\n", n_in, n_in > 0 ? in_sizes[0] : -1, out_size, ws_size, (size_t)WS_END); grid = -1; return; }
        int dev = 0, cus = 0, per_cu = 0;
        if (hipGetDevice(&dev) != hipSuccess || hipDeviceGetAttribute(&cus, hipDeviceAttributeMultiprocessorCount, dev) != hipSuccess) { grid = -1; return; }
        if (hipFuncSetAttribute((const void*)mk_fwd, hipFuncAttributeMaxDynamicSharedMemorySize, LDS_BYTES) != hipSuccess) { fprintf(stderr, "kernel_launch: hipFuncSetAttribute failed\n"); grid = -1; return; }
        if (hipOccupancyMaxActiveBlocksPerMultiprocessor(&per_cu, (const void*)mk_fwd, NWAVES * 64, LDS_BYTES) != hipSuccess || per_cu < 1) fprintf(stderr, "kernel_launch: occupancy query reports %d\n", per_cu);
        (void)hipGetLastError();
        grid = cus > 256 ? 256 : cus;
    }
    if (grid < 0) return;
    if (hipMemsetAsync((char*)d_ws + WS_CTL, 0, CTL_ZERO_BYTES, stream) != hipSuccess) return;
    Args a{};
    for (int i = 0; i < 14; ++i) a.in[i] = (const float*)d_in[i];
    a.out = (float*)d_out; a.ws = (unsigned char*)d_ws;
#if MK_SINGLE
    a.g_lo = 0; a.g_hi = NPHASE;
    hipLaunchKernelGGL(mk_fwd, dim3(grid), dim3(NWAVES * 64), LDS_BYTES, stream, a);
#else
    for (int g = 0; g < NPHASE; ++g) { a.g_lo = g; a.g_hi = g + 1; hipLaunchKernelGGL(mk_fwd, dim3(grid), dim3(NWAVES * 64), LDS_BYTES, stream, a); }
#endif
    const hipError_t le = hipPeekAtLastError();
    if (le != hipSuccess) fprintf(stderr, "kernel_launch: launch failed: %s\n", hipGetErrorName(le));
}
```

```cpp
#include <hip/hip_runtime.h>
#include <cstdio>
#include <cstdint>

#ifndef MK_SINGLE
#define MK_SINGLE 1
#endif

constexpr int NB = 2, SEQ = 16384, DM = 1024, DEPTH = 4, TOK = NB * SEQ;
constexpr int DIN = 6400, NEXP = 32, TOPK = 4, DFF = 1024, TK = TOK * TOPK;
constexpr int C_QA = 0, C_KA = 1024, C_VA = 2048, C_QB = 3072, C_KB = 4096, C_VB = 4224, C_GA = 4352, C_GB = 5376;
constexpr int MAXBLK = 544;
constexpr float LN_EPS = 1e-5f;
constexpr float DN_ALPHA = 1.6817928305074290f;
constexpr float LOG2E = 1.4426950408889634f;
constexpr float QA_SCALE = 0.08838834764831845f * LOG2E;
constexpr float QB_SCALE = 0.125f * LOG2E;
constexpr float SW_LIMIT = 7.0f, SW_ALPHA = 1.702f;

namespace pg8 {
#define PG8_LAS __attribute__((address_space(3)))
typedef unsigned short bf16_t;
typedef short bf16x8 __attribute__((ext_vector_type(8)));
typedef float f32x4 __attribute__((ext_vector_type(4)));
typedef float f32x2 __attribute__((ext_vector_type(2)));
typedef unsigned u32x4 __attribute__((ext_vector_type(4)));
typedef unsigned u32x2 __attribute__((ext_vector_type(2)));
typedef int i32x4 __attribute__((ext_vector_type(4)));
constexpr int BM = 256, BK = 64, HALF = 128, HTB = HALF * BK * 2  , STAGE_BYTES = 8 * HTB, NXCD = 8, WGM = 8;

__host__ __device__ __forceinline__ int lds_byte(int r, int c) { const int st = (r >> 4) * 2 + (c >> 5), rr = r & 15, cc = c & 31, ob = rr * 64 + cc * 2; return st * 1024 + (ob ^ (((ob >> 9) & 1) << 5)); }
__host__ __device__ __forceinline__ void stage_rc(int b, int& R, int& C) { const int st = b / 1024, sb = b % 1024, swz = sb ^ (((sb >> 9) & 1) << 5); R = (st >> 1) * 16 + swz / 64; C = (st & 1) * 32 + (swz % 64) / 2; }
__host__ __device__ __forceinline__ int perm32(int rho) { const int n = rho >> 4, i = rho & 15; return 8 * (i >> 2) + 4 * n + (i & 3); }

struct Unit { int pm, pn, e; };
struct Gemm { const bf16_t* A; const bf16_t* Bt; int M, N, K; size_t bstride; const int* rowidx; };

struct StaticOrder {
    int nM, nN, nwg, G, c; const int* blke;
    __device__ void init(int M, int N, int G_, int c_, const int* blke_) { nM = M / BM; nN = N / BM; nwg = nM * nN; G = G_; c = c_; blke = blke_; }
    __device__ bool next(int i, Unit& u) const {
        const long L = (long)i * G + c; if (L >= nwg) return false;
        int wgid = (int)L; { const int q = nwg / NXCD, r = nwg % NXCD, xcd = wgid % NXCD, off = wgid / NXCD; wgid = (xcd < r ? xcd * (q + 1) : r * (q + 1) + (xcd - r) * q) + off; }
        const int nig = WGM * nN, gid = wgid / nig, fm = gid * WGM, gsz = (nM - fm) < WGM ? (nM - fm) : WGM;
        u.pm = fm + ((wgid % nig) % gsz); u.pn = (wgid % nig) / gsz;
        u.e = blke ? __builtin_amdgcn_readfirstlane(__hip_atomic_load(blke + u.pm, __ATOMIC_RELAXED, __HIP_MEMORY_SCOPE_AGENT)) : 0;
        return true;
    }
    __device__ __forceinline__ void a_ready(const Unit&) const {}
    __device__ __forceinline__ void done(const Unit&) const {}
};

__device__ __forceinline__ int otid() { int t = threadIdx.x; asm volatile("" : "+v"(t)); return t; }
__device__ __forceinline__ unsigned cvt_pk_bf16(float lo, float hi) { unsigned r; asm volatile("v_cvt_pk_bf16_f32 %0, %1, %2" : "=v"(r) : "v"(lo), "v"(hi)); return r; }
__device__ __forceinline__ float fast_sigmoid(float x) { return __builtin_amdgcn_rcpf(1.0f + __builtin_amdgcn_exp2f(-x * 1.4426950408889634f)); }

struct EpiInProj {
    static constexpr bool PERM = true, AFTER_DRAIN = false;
    bf16_t* O;
    __device__ __forceinline__ void operator()(const f32x4 (&acc)[2][2][4][2], const Unit& u, int wr, int wc, int fr, int fq) const {
        const int row0 = u.pm * BM + wr * 64 + fr, col0 = u.pn * BM + wc * 32 + 8 * fq;
        const int pn = u.pn;
        const float sc = (pn < 4) ? QA_SCALE : ((pn >= 12 && pn < 16) ? QB_SCALE : 1.0f);
        const bool sig = pn >= 17;
#pragma unroll
        for (int ai = 0; ai < 2; ++ai)
#pragma unroll
            for (int m = 0; m < 4; ++m) { bf16_t* rowp = O + (size_t)(row0 + ai * HALF + m * 16) * DIN + col0;
#pragma unroll
                for (int bj = 0; bj < 2; ++bj) { f32x4 v0 = acc[ai][bj][m][0] * sc, v1 = acc[ai][bj][m][1] * sc;
                    if (sig) {
#pragma unroll
                        for (int q = 0; q < 4; ++q) { v0[q] = fast_sigmoid(v0[q]); v1[q] = fast_sigmoid(v1[q]); } }
                    u32x4 w; w.x = cvt_pk_bf16(v0[0], v0[1]); w.y = cvt_pk_bf16(v0[2], v0[3]); w.z = cvt_pk_bf16(v1[0], v1[1]); w.w = cvt_pk_bf16(v1[2], v1[3]);
                    *(u32x4*)(rowp + bj * HALF) = w; } }
    }
};
struct EpiInProjI8 {
    static constexpr bool PERM = true, AFTER_DRAIN = false;
    bf16_t* O; const float* sx; const float* sw;
    __device__ __forceinline__ void operator()(const f32x4 (&acc)[2][2][4][2], const Unit& u, int wr, int wc, int fr, int fq) const {
        const int row0 = u.pm * BM + wr * 64 + fr, col0 = u.pn * BM + wc * 32 + 8 * fq;
        const int pn = u.pn;
        const float sc = (pn < 4) ? QA_SCALE : ((pn >= 12 && pn < 16) ? QB_SCALE : 1.0f);
        const bool sig = pn >= 17;
        f32x4 cw[2][2];
#pragma unroll
        for (int bj = 0; bj < 2; ++bj)
#pragma unroll
            for (int n = 0; n < 2; ++n) cw[bj][n] = *(const f32x4*)(sw + col0 + bj * HALF + 4 * n) * sc;
#pragma unroll
        for (int ai = 0; ai < 2; ++ai)
#pragma unroll
            for (int m = 0; m < 4; ++m) { const int row = row0 + ai * HALF + m * 16; const float rs = sx[row]; bf16_t* rowp = O + (size_t)row * DIN + col0;
#pragma unroll
                for (int bj = 0; bj < 2; ++bj) { const i32x4 i0 = __builtin_bit_cast(i32x4, acc[ai][bj][m][0]), i1 = __builtin_bit_cast(i32x4, acc[ai][bj][m][1]);
                    f32x4 v0 = (f32x4){(float)i0[0], (float)i0[1], (float)i0[2], (float)i0[3]} * cw[bj][0] * rs, v1 = (f32x4){(float)i1[0], (float)i1[1], (float)i1[2], (float)i1[3]} * cw[bj][1] * rs;
                    if (sig) {
#pragma unroll
                        for (int q = 0; q < 4; ++q) { v0[q] = fast_sigmoid(v0[q]); v1[q] = fast_sigmoid(v1[q]); } }
                    u32x4 w; w.x = cvt_pk_bf16(v0[0], v0[1]); w.y = cvt_pk_bf16(v0[2], v0[3]); w.z = cvt_pk_bf16(v1[0], v1[1]); w.w = cvt_pk_bf16(v1[2], v1[3]);
                    *(u32x4*)(rowp + bj * HALF) = w; } }
    }
};
struct EpiF32 {
    static constexpr bool PERM = false, AFTER_DRAIN = false;
    float* O; int ldc; const float* bias; int bias_stride;
    __device__ __forceinline__ void operator()(const f32x4 (&acc)[2][2][4][2], const Unit& u, int wr, int wc, int fr, int fq) const {
        const int row0 = u.pm * BM + wr * 64 + fr, col0 = u.pn * BM + wc * 32 + 4 * fq;
        f32x4 bv[2][2];
#pragma unroll
        for (int bj = 0; bj < 2; ++bj)
#pragma unroll
            for (int n = 0; n < 2; ++n) bv[bj][n] = bias ? *(const f32x4*)(bias + (size_t)u.e * bias_stride + col0 + bj * HALF + n * 16) : (f32x4){0.f, 0.f, 0.f, 0.f};
#pragma unroll
        for (int ai = 0; ai < 2; ++ai)
#pragma unroll
            for (int m = 0; m < 4; ++m) { float* rowp = O + (size_t)(row0 + ai * HALF + m * 16) * ldc + col0;
#pragma unroll
                for (int bj = 0; bj < 2; ++bj)
#pragma unroll
                    for (int n = 0; n < 2; ++n) *(f32x4*)(rowp + bj * HALF + n * 16) = acc[ai][bj][m][n] + bv[bj][n]; }
    }
};
struct EpiBf16Bias {
    static constexpr bool PERM = true, AFTER_DRAIN = false;
    bf16_t* O; int ldc; const float* bias; int bias_stride;
    __device__ __forceinline__ void operator()(const f32x4 (&acc)[2][2][4][2], const Unit& u, int wr, int wc, int fr, int fq) const {
        const int row0 = u.pm * BM + wr * 64 + fr, col0 = u.pn * BM + wc * 32 + 8 * fq;
        f32x4 bv[2][2];
#pragma unroll
        for (int bj = 0; bj < 2; ++bj)
#pragma unroll
            for (int n = 0; n < 2; ++n) bv[bj][n] = bias ? *(const f32x4*)(bias + (size_t)u.e * bias_stride + col0 + bj * HALF + 4 * n) : (f32x4){0.f, 0.f, 0.f, 0.f};
#pragma unroll
        for (int ai = 0; ai < 2; ++ai)
#pragma unroll
            for (int m = 0; m < 4; ++m) { bf16_t* rowp = O + (size_t)(row0 + ai * HALF + m * 16) * ldc + col0;
#pragma unroll
                for (int bj = 0; bj < 2; ++bj) { const f32x4 v0 = acc[ai][bj][m][0] + bv[bj][0], v1 = acc[ai][bj][m][1] + bv[bj][1];
                    u32x4 w; w.x = cvt_pk_bf16(v0[0], v0[1]); w.y = cvt_pk_bf16(v0[2], v0[3]); w.z = cvt_pk_bf16(v1[0], v1[1]); w.w = cvt_pk_bf16(v1[2], v1[3]);
                    *(u32x4*)(rowp + bj * HALF) = w; } }
    }
};
struct EpiBf16I8 {
    static constexpr bool PERM = true, AFTER_DRAIN = false;
    bf16_t* O; int ldc; const float* srow; const float* scol;
    __device__ __forceinline__ void operator()(const f32x4 (&acc)[2][2][4][2], const Unit& u, int wr, int wc, int fr, int fq) const {
        const int row0 = u.pm * BM + wr * 64 + fr, col0 = u.pn * BM + wc * 32 + 8 * fq;
        f32x4 cw[2][2];
#pragma unroll
        for (int bj = 0; bj < 2; ++bj)
#pragma unroll
            for (int n = 0; n < 2; ++n) cw[bj][n] = *(const f32x4*)(scol + col0 + bj * HALF + 4 * n);
#pragma unroll
        for (int ai = 0; ai < 2; ++ai)
#pragma unroll
            for (int m = 0; m < 4; ++m) { const int row = row0 + ai * HALF + m * 16; const float rs = srow[row]; bf16_t* rowp = O + (size_t)row * ldc + col0;
#pragma unroll
                for (int bj = 0; bj < 2; ++bj) { const i32x4 i0 = __builtin_bit_cast(i32x4, acc[ai][bj][m][0]), i1 = __builtin_bit_cast(i32x4, acc[ai][bj][m][1]);
                    const f32x4 v0 = (f32x4){(float)i0[0], (float)i0[1], (float)i0[2], (float)i0[3]} * cw[bj][0] * rs, v1 = (f32x4){(float)i1[0], (float)i1[1], (float)i1[2], (float)i1[3]} * cw[bj][1] * rs;
                    u32x4 w; w.x = cvt_pk_bf16(v0[0], v0[1]); w.y = cvt_pk_bf16(v0[2], v0[3]); w.z = cvt_pk_bf16(v1[0], v1[1]); w.w = cvt_pk_bf16(v1[2], v1[3]);
                    *(u32x4*)(rowp + bj * HALF) = w; } }
    }
};
struct EpiSwiGLUI8 {
    static constexpr bool PERM = true, AFTER_DRAIN = false;
    bf16_t* O; const float* bias; const float* srow; const float* scol;
    __device__ __forceinline__ float act(float g, float up) const {
        g = fminf(g, SW_LIMIT); up = fminf(fmaxf(up, -SW_LIMIT), SW_LIMIT);
        return (up + 1.0f) * (g * __builtin_amdgcn_rcpf(1.0f + __builtin_amdgcn_exp2f(-SW_ALPHA * LOG2E * g)));
    }
    __device__ __forceinline__ void operator()(const f32x4 (&acc)[2][2][4][2], const Unit& u, int wr, int wc, int fr, int fq) const {
        const int row0 = u.pm * BM + wr * 64 + fr, col0 = u.pn * BM + wc * 32 + 8 * fq;
        f32x4 bv[2][2], cw[2][2];
#pragma unroll
        for (int bj = 0; bj < 2; ++bj)
#pragma unroll
            for (int n = 0; n < 2; ++n) { bv[bj][n] = *(const f32x4*)(bias + (size_t)u.e * (2 * DFF) + col0 + bj * HALF + 4 * n); cw[bj][n] = *(const f32x4*)(scol + (size_t)u.e * (2 * DFF) + col0 + bj * HALF + 4 * n); }
#pragma unroll
        for (int ai = 0; ai < 2; ++ai)
#pragma unroll
            for (int m = 0; m < 4; ++m) { const int row = row0 + ai * HALF + m * 16; const float rs = srow[row]; bf16_t* rowp = O + (size_t)row * DFF + (col0 >> 1);
#pragma unroll
                for (int bj = 0; bj < 2; ++bj) { const i32x4 i0 = __builtin_bit_cast(i32x4, acc[ai][bj][m][0]), i1 = __builtin_bit_cast(i32x4, acc[ai][bj][m][1]);
                    const f32x4 v0 = (f32x4){(float)i0[0], (float)i0[1], (float)i0[2], (float)i0[3]} * cw[bj][0] * rs + bv[bj][0], v1 = (f32x4){(float)i1[0], (float)i1[1], (float)i1[2], (float)i1[3]} * cw[bj][1] * rs + bv[bj][1];
                    u32x2 w; w.x = cvt_pk_bf16(act(v0[0], v0[1]), act(v0[2], v0[3])); w.y = cvt_pk_bf16(act(v1[0], v1[1]), act(v1[2], v1[3]));
                    *(u32x2*)(rowp + bj * (HALF / 2)) = w; } }
    }
};
struct EpiSwiGLU {
    static constexpr bool PERM = true, AFTER_DRAIN = false;
    bf16_t* O; const float* bias;
    __device__ __forceinline__ float act(float g, float up) const {
        g = fminf(g, SW_LIMIT); up = fminf(fmaxf(up, -SW_LIMIT), SW_LIMIT);
        return (up + 1.0f) * (g * __builtin_amdgcn_rcpf(1.0f + __builtin_amdgcn_exp2f(-SW_ALPHA * LOG2E * g)));
    }
    __device__ __forceinline__ void operator()(const f32x4 (&acc)[2][2][4][2], const Unit& u, int wr, int wc, int fr, int fq) const {
        const int row0 = u.pm * BM + wr * 64 + fr, col0 = u.pn * BM + wc * 32 + 8 * fq;
        f32x4 bv[2][2];
#pragma unroll
        for (int bj = 0; bj < 2; ++bj)
#pragma unroll
            for (int n = 0; n < 2; ++n) bv[bj][n] = *(const f32x4*)(bias + (size_t)u.e * (2 * DFF) + col0 + bj * HALF + 4 * n);
#pragma unroll
        for (int ai = 0; ai < 2; ++ai)
#pragma unroll
            for (int m = 0; m < 4; ++m) { bf16_t* rowp = O + (size_t)(row0 + ai * HALF + m * 16) * DFF + (col0 >> 1);
#pragma unroll
                for (int bj = 0; bj < 2; ++bj) { const f32x4 v0 = acc[ai][bj][m][0] + bv[bj][0], v1 = acc[ai][bj][m][1] + bv[bj][1];
                    u32x2 w; w.x = cvt_pk_bf16(act(v0[0], v0[1]), act(v0[2], v0[3])); w.y = cvt_pk_bf16(act(v1[0], v1[1]), act(v1[2], v1[3]));
                    *(u32x2*)(rowp + bj * (HALF / 2)) = w; } }
    }
};

template <class Epi, class Sched, bool ALIGN_EPI = false, bool SP2 = false, bool GATHER = false, bool I8 = false>
__device__ __forceinline__ void gemm_phase(PG8_LAS unsigned char* lds, const Gemm g, const Sched& S, const Epi& E) {
    const int tid = otid(), wid = __builtin_amdgcn_readfirstlane(tid >> 6), lane = tid & 63, wr = wid >> 2, wc = wid & 3, fr = lane & 15, fq = lane >> 4;
    const int K = g.K, nt = K / BK;
    unsigned voffA[2], voffB[2];
#pragma unroll
    for (int i = 0; i < 2; ++i) { int R, C; stage_rc(tid * 16 + i * 8192, R, C); const int Rb = Epi::PERM ? ((R & ~31) + perm32(R & 31)) : R;
        voffA[i] = (unsigned)(R * K + C) * 2u; voffB[i] = (unsigned)(Rb * K + C) * 2u; }
    PG8_LAS int* ltok = (PG8_LAS int*)(lds + STAGE_BYTES);
    int gR[2], gC[2];
#pragma unroll
    for (int i = 0; i < 2; ++i) { int R, C; stage_rc(tid * 16 + i * 8192, R, C); gR[i] = R; gC[i] = C * 2; }
    unsigned vcur[2][2], vnxt[2][2];
    const char* gA = (const char*)g.A;
#define PG8_GOFF(dst, ui_) do { _Pragma("unroll") for (int h_ = 0; h_ < 2; ++h_) _Pragma("unroll") for (int i_ = 0; i_ < 2; ++i_) \
        dst[h_][i_] = (unsigned)ltok[(ui_) * 256 + h_ * HALF + gR[i_]] * (unsigned)(K * 2) + (unsigned)gC[i_]; } while (0)
    if constexpr (GATHER) {
        Unit u_; for (int i = 0; S.next(i, u_); ++i) { if (tid < 256) ltok[i * 256 + tid] = g.rowidx[u_.pm * BM + tid]; }
        __syncthreads();
    }
    const size_t kstep = (size_t)(BK * 2);
    const size_t hstep = (size_t)HALF * K * 2;
    const size_t tstep = 2 * hstep;
    const unsigned ldsw = (unsigned)wid * 1024u;
    const int aoff = lds_byte(wr * 64 + fr, fq * 8), boff = lds_byte(wc * 32 + fr, fq * 8);
#define PG8_SA(b, h) (((b) * 2 + (h)) * HTB)
#define PG8_SB(b, h) ((4 + (b) * 2 + (h)) * HTB)
#define PG8_STAGE(bufoff, gbase, voff) do { _Pragma("unroll") for (int _i = 0; _i < 2; ++_i) \
        __builtin_amdgcn_global_load_lds((const unsigned*)((const char*)(gbase) + (voff)[_i]), (PG8_LAS unsigned*)(lds + (bufoff) + ldsw + _i * 8192), 16, 0, 0); } while (0)
#define PG8_LDA(dst, b, h) do { _Pragma("unroll") for (int m = 0; m < 4; ++m) _Pragma("unroll") for (int k = 0; k < 2; ++k) dst[m][k] = *(const PG8_LAS bf16x8*)(lds + PG8_SA(b, h) + aoff + m * 2048 + k * 1024); } while (0)
#define PG8_LDB(dst, b, h) do { _Pragma("unroll") for (int n = 0; n < 2; ++n) _Pragma("unroll") for (int k = 0; k < 2; ++k) dst[n][k] = *(const PG8_LAS bf16x8*)(lds + PG8_SB(b, h) + boff + n * 2048 + k * 1024); } while (0)
#define PG8_MMA(ai, bj, At, Bt) do { __builtin_amdgcn_s_setprio(1); _Pragma("unroll") for (int m = 0; m < 4; ++m) _Pragma("unroll") for (int n = 0; n < 2; ++n) _Pragma("unroll") for (int k = 0; k < 2; ++k) { \
        if constexpr (I8) acc[ai][bj][m][n] = __builtin_bit_cast(f32x4, __builtin_amdgcn_mfma_i32_16x16x64_i8(__builtin_bit_cast(i32x4, Bt[n][k]), __builtin_bit_cast(i32x4, At[m][k]), __builtin_bit_cast(i32x4, acc[ai][bj][m][n]), 0, 0, 0)); \
        else acc[ai][bj][m][n] = __builtin_amdgcn_mfma_f32_16x16x32_bf16(Bt[n][k], At[m][k], acc[ai][bj][m][n], 0, 0, 0); } __builtin_amdgcn_s_setprio(0); } while (0)
#define PG8_WAIT_V(n) asm volatile("s_waitcnt vmcnt(" #n ")" ::: "memory")
#define PG8_WAIT_L(n) asm volatile("s_waitcnt lgkmcnt(" #n ")" ::: "memory")
#define PG8_BAR __builtin_amdgcn_s_barrier()
#define PG8_SCHED __builtin_amdgcn_sched_barrier(0)
    Unit cur, nxt; int ui = 0;
    if (!S.next(0, cur)) return;
    f32x4 acc[2][2][4][2];
#pragma unroll
    for (int a = 0; a < 2; ++a)
#pragma unroll
        for (int b = 0; b < 2; ++b)
#pragma unroll
            for (int m = 0; m < 4; ++m)
#pragma unroll
                for (int n = 0; n < 2; ++n) acc[a][b][m][n] = (f32x4){0.f, 0.f, 0.f, 0.f};
    bf16x8 At[4][2], B0[2][2], B1[2][2];
    const char* cA = (const char*)g.A + (size_t)cur.pm * tstep; const char* cB = (const char*)g.Bt + (size_t)cur.e * g.bstride + (size_t)cur.pn * tstep;
    S.a_ready(cur);
    if constexpr (GATHER) { PG8_GOFF(vcur, 0); }
    if constexpr (SP2) {
        PG8_STAGE(PG8_SB(0, 0), cB, voffB); PG8_STAGE(PG8_SB(0, 1), cB + hstep, voffB);
        if constexpr (GATHER) { PG8_STAGE(PG8_SA(0, 0), gA, vcur[0]); PG8_STAGE(PG8_SA(0, 1), gA, vcur[1]); } else { PG8_STAGE(PG8_SA(0, 0), cA, voffA); PG8_STAGE(PG8_SA(0, 1), cA + hstep, voffA); }
        if (wr == 1) PG8_BAR;
        PG8_WAIT_V(2); PG8_BAR;
        PG8_STAGE(PG8_SB(1, 0), cB + kstep, voffB); if constexpr (GATHER) { PG8_STAGE(PG8_SA(1, 0), gA + kstep, vcur[0]); } else { PG8_STAGE(PG8_SA(1, 0), cA + kstep, voffA); } PG8_STAGE(PG8_SB(1, 1), cB + hstep + kstep, voffB);
        PG8_WAIT_V(6); PG8_BAR;
    } else {
        PG8_STAGE(PG8_SB(0, 0), cB, voffB); PG8_STAGE(PG8_SA(0, 0), cA, voffA); PG8_STAGE(PG8_SB(0, 1), cB + hstep, voffB); PG8_STAGE(PG8_SA(0, 1), cA + hstep, voffA);
        if (wr == 1) PG8_BAR;
        PG8_WAIT_V(4); PG8_BAR;
        PG8_STAGE(PG8_SB(1, 0), cB + kstep, voffB); PG8_STAGE(PG8_SA(1, 0), cA + kstep, voffA); PG8_STAGE(PG8_SB(1, 1), cB + hstep + kstep, voffB);
        PG8_WAIT_V(6); PG8_BAR;
    }
    for (;;) {
        const bool has_next = S.next(ui + 1, nxt);
        if constexpr (GATHER) { if (has_next) { PG8_GOFF(vnxt, ui + 1); } else { _Pragma("unroll") for (int h_ = 0; h_ < 2; ++h_) _Pragma("unroll") for (int i_ = 0; i_ < 2; ++i_) vnxt[h_][i_] = vcur[h_][i_]; } }
        const char* nA = has_next ? (const char*)g.A + (size_t)nxt.pm * tstep : cA; const char* nB = has_next ? (const char*)g.Bt + (size_t)nxt.e * g.bstride + (size_t)nxt.pn * tstep : cB;
#pragma unroll 1
        for (int t = 0; t < nt; t += 2) {
            const bool last = (t == nt - 2);
            const char* a1 = cA + (size_t)(t + 1) * kstep;
            const char* a2 = last ? nA : cA + (size_t)(t + 2) * kstep; const char* b2 = last ? nB : cB + (size_t)(t + 2) * kstep;
            const char* a3 = a2 + kstep; const char* b3 = b2 + kstep;
            const size_t ko1 = (size_t)(t + 1) * kstep, ko2 = last ? (size_t)0 : (size_t)(t + 2) * kstep, ko3 = ko2 + kstep; unsigned v2[2][2];
            if constexpr (GATHER) { _Pragma("unroll") for (int h_ = 0; h_ < 2; ++h_) _Pragma("unroll") for (int i_ = 0; i_ < 2; ++i_) v2[h_][i_] = last ? vnxt[h_][i_] : vcur[h_][i_]; }
            if (last && has_next) S.a_ready(nxt);
            if constexpr (SP2) {
            PG8_LDB(B0, 0, 0); PG8_LDB(B1, 0, 1); PG8_SCHED; PG8_LDA(At, 0, 0); if constexpr (GATHER) { PG8_STAGE(PG8_SA(1, 1), gA + ko1, vcur[1]); } else { PG8_STAGE(PG8_SA(1, 1), a1 + hstep, voffA); }
            PG8_WAIT_V(8); PG8_WAIT_L(0); PG8_BAR; PG8_MMA(0, 0, At, B0); PG8_MMA(0, 1, At, B1); PG8_BAR; PG8_SCHED;
            PG8_LDA(At, 0, 1); PG8_STAGE(PG8_SB(0, 0), b2, voffB); PG8_STAGE(PG8_SB(0, 1), b2 + hstep, voffB); if constexpr (GATHER) { PG8_STAGE(PG8_SA(0, 0), gA + ko2, v2[0]); } else { PG8_STAGE(PG8_SA(0, 0), a2, voffA); }
            PG8_WAIT_V(8); PG8_WAIT_L(0); PG8_BAR; PG8_MMA(1, 0, At, B0); PG8_MMA(1, 1, At, B1); PG8_BAR; PG8_SCHED;
            PG8_LDB(B0, 1, 0); PG8_LDB(B1, 1, 1); PG8_SCHED; PG8_LDA(At, 1, 0); if constexpr (GATHER) { PG8_STAGE(PG8_SA(0, 1), gA + ko2, v2[1]); } else { PG8_STAGE(PG8_SA(0, 1), a2 + hstep, voffA); }
            PG8_WAIT_V(8); PG8_WAIT_L(0); PG8_BAR; PG8_MMA(0, 0, At, B0); PG8_MMA(0, 1, At, B1); PG8_BAR; PG8_SCHED;
            PG8_LDA(At, 1, 1); PG8_STAGE(PG8_SB(1, 0), b3, voffB); PG8_STAGE(PG8_SB(1, 1), b3 + hstep, voffB); if constexpr (GATHER) { PG8_STAGE(PG8_SA(1, 0), gA + ko3, v2[0]); } else { PG8_STAGE(PG8_SA(1, 0), a3, voffA); }
            PG8_WAIT_V(8); PG8_WAIT_L(0); PG8_BAR; PG8_MMA(1, 0, At, B0); PG8_MMA(1, 1, At, B1); PG8_BAR; PG8_SCHED;
            } else {
            PG8_LDB(B0, 0, 0); PG8_SCHED; PG8_LDA(At, 0, 0); PG8_STAGE(PG8_SA(1, 1), a1 + hstep, voffA);
            PG8_WAIT_L(8); PG8_BAR; PG8_WAIT_L(0); PG8_MMA(0, 0, At, B0); PG8_BAR; PG8_SCHED;
            PG8_LDB(B1, 0, 1); PG8_STAGE(PG8_SB(0, 0), b2, voffB);
            PG8_BAR; PG8_WAIT_L(0); PG8_MMA(0, 1, At, B1); PG8_BAR;
            PG8_LDA(At, 0, 1); PG8_STAGE(PG8_SA(0, 0), a2, voffA);
            PG8_BAR; PG8_WAIT_L(0); PG8_MMA(1, 0, At, B0); PG8_BAR; PG8_SCHED;
            PG8_STAGE(PG8_SB(0, 1), b2 + hstep, voffB);
            PG8_WAIT_V(6); PG8_BAR; PG8_MMA(1, 1, At, B1); PG8_BAR;
            PG8_LDB(B0, 1, 0); PG8_SCHED; PG8_LDA(At, 1, 0); PG8_STAGE(PG8_SA(0, 1), a2 + hstep, voffA);
            PG8_WAIT_L(8); PG8_BAR; PG8_WAIT_L(0); PG8_MMA(0, 0, At, B0); PG8_BAR; PG8_SCHED;
            PG8_LDB(B1, 1, 1); PG8_STAGE(PG8_SB(1, 0), b3, voffB);
            PG8_BAR; PG8_WAIT_L(0); PG8_MMA(0, 1, At, B1); PG8_BAR;
            PG8_LDA(At, 1, 1); PG8_STAGE(PG8_SA(1, 0), a3, voffA);
            PG8_BAR; PG8_WAIT_L(0); PG8_MMA(1, 0, At, B0); PG8_BAR; PG8_SCHED;
            PG8_STAGE(PG8_SB(1, 1), b3 + hstep, voffB);
            PG8_WAIT_V(6); PG8_BAR; PG8_MMA(1, 1, At, B1); PG8_BAR;
            }
        }
        if constexpr (ALIGN_EPI) { if (wr == 0) PG8_BAR; }
        if constexpr (!Epi::AFTER_DRAIN) { E(acc, cur, wr, wc, fr, fq); S.done(cur); }
        if (!has_next) break;
#pragma unroll
        for (int a = 0; a < 2; ++a)
#pragma unroll
            for (int b = 0; b < 2; ++b)
#pragma unroll
                for (int m = 0; m < 4; ++m)
#pragma unroll
                    for (int n = 0; n < 2; ++n) acc[a][b][m][n] = (f32x4){0.f, 0.f, 0.f, 0.f};
        cur = nxt; cA = nA; cB = nB; ++ui;
        if constexpr (GATHER) { _Pragma("unroll") for (int h_ = 0; h_ < 2; ++h_) _Pragma("unroll") for (int i_ = 0; i_ < 2; ++i_) vcur[h_][i_] = vnxt[h_][i_]; }
        if constexpr (ALIGN_EPI) { if (wr == 1) PG8_BAR; }
    }
    PG8_WAIT_V(0);
    if constexpr (!ALIGN_EPI) { if (wr == 0) PG8_BAR; }
    PG8_BAR;
    if constexpr (Epi::AFTER_DRAIN) { E.fused(acc, cur, wr, wc, fr, fq, lds, wid, lane); S.done(cur); }
#undef PG8_SA
#undef PG8_GOFF
#undef PG8_SB
#undef PG8_STAGE
#undef PG8_LDA
#undef PG8_LDB
#undef PG8_MMA
#undef PG8_WAIT_V
#undef PG8_WAIT_L
#undef PG8_BAR
#undef PG8_SCHED
}

}

namespace att {
typedef unsigned short bf16_t;
using bf16x8 = __attribute__((ext_vector_type(8))) short;
using s16x4  = __attribute__((ext_vector_type(4))) short;
using f32x16 = __attribute__((ext_vector_type(16))) float;
using f32x4  = __attribute__((ext_vector_type(4))) float;
using u32x4  = __attribute__((ext_vector_type(4))) unsigned;
#define ATT_LAS __attribute__((address_space(3)))
#define SBAR() __builtin_amdgcn_sched_barrier(0)
constexpr int PITCH = DIN;
constexpr float THR = 8.0f;
constexpr float NEG_BIG = -1e30f;
constexpr int FL_K = 0, FL_KB = 8192, FL_V = 24576, FL_VB = 16384, FL_WS = 98304, FL_Q = 100352;
constexpr int SW_K = 0, SW_V = 49152, SW_VT = 8192;
constexpr int NQR = 4;
constexpr int FL_FLG = FL_Q + 8 * (8 - NQR) * 1024;
constexpr int ATT_LDS = FL_FLG + 64;

__device__ __forceinline__ int crow(int r, int hi) { return (r & 3) + 8 * (r >> 2) + 4 * hi; }
__device__ __forceinline__ unsigned cvtpk(float lo, float hi) { unsigned r; asm volatile("v_cvt_pk_bf16_f32 %0, %1, %2" : "=v"(r) : "v"(lo), "v"(hi)); return r; }
__device__ __forceinline__ int kswz256(int row, int colB) { return row * 256 + (colB ^ ((row & 7) << 4)); }
__device__ __forceinline__ int kswz128(int row, int colB) { return row * 128 + (colB ^ ((row & 7) << 4)); }
template <int NCB> __device__ __forceinline__ int v_st(int k, int c) { const int kk = (k & ~0xC) | ((k & 4) << 1) | ((k & 8) >> 1); return ((kk >> 3) * NCB + (c >> 5)) * 512 + ((kk & 7) * 32 + (c & 31)) * 2; }
__device__ __forceinline__ int v_rd_base(int lane) { return ((lane & 3) << 3) | (((lane >> 2) & 3) << 6) | (((lane >> 4) & 1) << 5) | (((lane >> 5) & 1) << 8); }
template <int NCB> constexpr int v_rd_off(int d0, int ks, int half) { return d0 * 512 + (2 * ks + half) * NCB * 512; }
template <int OFF> __device__ __forceinline__ s16x4 tr_read(int vb) { s16x4 r; asm volatile("ds_read_b64_tr_b16 %0, %1 offset:%2" : "=&v"(r) : "v"(vb), "i"(OFF) : "memory"); return r; }
template <int NCB, int D0> __device__ __forceinline__ void pv_one(f32x16& od, int vb, bf16x8 pa0, bf16x8 pa1, bf16x8 pa2, bf16x8 pa3) {
    const s16x4 l0 = tr_read<v_rd_off<NCB>(D0, 0, 0)>(vb), h0 = tr_read<v_rd_off<NCB>(D0, 0, 1)>(vb), l1 = tr_read<v_rd_off<NCB>(D0, 1, 0)>(vb), h1 = tr_read<v_rd_off<NCB>(D0, 1, 1)>(vb);
    const s16x4 l2 = tr_read<v_rd_off<NCB>(D0, 2, 0)>(vb), h2 = tr_read<v_rd_off<NCB>(D0, 2, 1)>(vb), l3 = tr_read<v_rd_off<NCB>(D0, 3, 0)>(vb), h3 = tr_read<v_rd_off<NCB>(D0, 3, 1)>(vb);
    asm volatile("s_waitcnt lgkmcnt(0)" ::: "memory"); SBAR();
#define PK(L, H) (bf16x8){L[0], L[1], L[2], L[3], H[0], H[1], H[2], H[3]}
    od = __builtin_amdgcn_mfma_f32_32x32x16_bf16(pa0, PK(l0, h0), od, 0, 0, 0);
    od = __builtin_amdgcn_mfma_f32_32x32x16_bf16(pa1, PK(l1, h1), od, 0, 0, 0);
    od = __builtin_amdgcn_mfma_f32_32x32x16_bf16(pa2, PK(l2, h2), od, 0, 0, 0);
    od = __builtin_amdgcn_mfma_f32_32x32x16_bf16(pa3, PK(l3, h3), od, 0, 0, 0);
#undef PK
}
__device__ __forceinline__ float half_max(float v) { auto rr = __builtin_amdgcn_permlane32_swap(__float_as_uint(v), __float_as_uint(v), false, false); return fmaxf(__uint_as_float(rr[0]), __uint_as_float(rr[1])); }
__device__ __forceinline__ float half_sum(float v) { auto rr = __builtin_amdgcn_permlane32_swap(__float_as_uint(v), __float_as_uint(v), false, false); return __uint_as_float(rr[0]) + __uint_as_float(rr[1]); }
__device__ __forceinline__ float softmax_step(f32x16& p0, f32x16& p1, float& m_reg, float& l_reg) {
    float pmax = p0[0];
#pragma unroll
    for (int r = 1; r < 16; ++r) pmax = fmaxf(pmax, p0[r]);
#pragma unroll
    for (int r = 0; r < 16; ++r) pmax = fmaxf(pmax, p1[r]);
    pmax = half_max(pmax);
    float alpha = 1.f;
    if (!__all(pmax - m_reg <= THR)) { const float mn = fmaxf(m_reg, pmax); alpha = __builtin_amdgcn_exp2f(m_reg - mn); m_reg = mn; }
    float ps = 0.f;
#pragma unroll
    for (int r = 0; r < 16; ++r) { p0[r] = __builtin_amdgcn_exp2f(p0[r] - m_reg); ps += p0[r]; }
#pragma unroll
    for (int r = 0; r < 16; ++r) { p1[r] = __builtin_amdgcn_exp2f(p1[r] - m_reg); ps += p1[r]; }
    ps = half_sum(ps);
    l_reg = l_reg * alpha + ps;
    return alpha;
}
__device__ __forceinline__ void pack_p(const f32x16& p0, const f32x16& p1, bf16x8& pa0, bf16x8& pa1, bf16x8& pa2, bf16x8& pa3) {
#define PK4(P, BASE, OUT) do { unsigned a0 = cvtpk(P[BASE + 0], P[BASE + 1]), a1 = cvtpk(P[BASE + 2], P[BASE + 3]);   \
    unsigned b0 = cvtpk(P[BASE + 4], P[BASE + 5]), b1 = cvtpk(P[BASE + 6], P[BASE + 7]);                              \
    auto r0 = __builtin_amdgcn_permlane32_swap(a0, b0, false, false); auto r1 = __builtin_amdgcn_permlane32_swap(a1, b1, false, false); \
    u32x4 w = {r0[0], r1[0], r0[1], r1[1]}; OUT = __builtin_bit_cast(bf16x8, w); } while (0)
    PK4(p0, 0, pa0); PK4(p0, 8, pa1); PK4(p1, 0, pa2); PK4(p1, 8, pa3);
#undef PK4
}

struct AttnArgs {
    const bf16_t* proj;
    bf16_t* merged;
    bf16_t* oc;
    const float* subln_g;
    const float* sinks;
    float lam, one_m_lam_init;
    const unsigned* kmax2;
};

#define FPK(L, H) (bf16x8){L[0], L[1], L[2], L[3], H[0], H[1], H[2], H[3]}
#define RDV32(L0, H0, L1, H1, VB, D0) do { L0 = tr_read<v_rd_off<4>(D0, 0, 0)>(VB); H0 = tr_read<v_rd_off<4>(D0, 0, 1)>(VB); L1 = tr_read<v_rd_off<4>(D0, 1, 0)>(VB); H1 = tr_read<v_rd_off<4>(D0, 1, 1)>(VB); } while (0)
#define MMV32(OD, L0, H0, L1, H1) do { OD = __builtin_amdgcn_mfma_f32_32x32x16_bf16(pa0, FPK(L0, H0), OD, 0, 0, 0); OD = __builtin_amdgcn_mfma_f32_32x32x16_bf16(pa1, FPK(L1, H1), OD, 0, 0, 0); } while (0)
#define WAITL32(N) do { asm volatile("s_waitcnt lgkmcnt(" #N ")" ::: "memory"); SBAR(); } while (0)
#define PV32_PIPE(o, vb, V0, V1, V2, V3, V4, V5, V6, V7) do { const int vb1_ = (vb) + 8192; s16x4 al0, ah0, al1, ah1, bl0, bh0, bl1, bh1; \
        RDV32(al0, ah0, al1, ah1, vb, 0); \
        RDV32(bl0, bh0, bl1, bh1, vb, 1);   WAITL32(4); MMV32(o[0], al0, ah0, al1, ah1); V0; SBAR(); \
        RDV32(al0, ah0, al1, ah1, vb, 2);   WAITL32(4); MMV32(o[1], bl0, bh0, bl1, bh1); V1; SBAR(); \
        RDV32(bl0, bh0, bl1, bh1, vb, 3);   WAITL32(4); MMV32(o[2], al0, ah0, al1, ah1); V2; SBAR(); \
        RDV32(al0, ah0, al1, ah1, vb1_, 0); WAITL32(4); MMV32(o[3], bl0, bh0, bl1, bh1); V3; SBAR(); \
        RDV32(bl0, bh0, bl1, bh1, vb1_, 1); WAITL32(4); MMV32(o[4], al0, ah0, al1, ah1); V4; SBAR(); \
        RDV32(al0, ah0, al1, ah1, vb1_, 2); WAITL32(4); MMV32(o[5], bl0, bh0, bl1, bh1); V5; SBAR(); \
        RDV32(bl0, bh0, bl1, bh1, vb1_, 3); WAITL32(4); MMV32(o[6], al0, ah0, al1, ah1); V6; SBAR(); \
        WAITL32(0); MMV32(o[7], bl0, bh0, bl1, bh1); V7; SBAR(); } while (0)
__device__ __forceinline__ void pack32(const f32x16& p, bf16x8& pa0, bf16x8& pa1) {
#define PK4(P, BASE, OUT) do { unsigned a0 = cvtpk(P[BASE + 0], P[BASE + 1]), a1 = cvtpk(P[BASE + 2], P[BASE + 3]);   \
    unsigned b0 = cvtpk(P[BASE + 4], P[BASE + 5]), b1 = cvtpk(P[BASE + 6], P[BASE + 7]);                              \
    auto r0 = __builtin_amdgcn_permlane32_swap(a0, b0, false, false); auto r1 = __builtin_amdgcn_permlane32_swap(a1, b1, false, false); \
    u32x4 w = {r0[0], r1[0], r0[1], r1[1]}; OUT = __builtin_bit_cast(bf16x8, w); } while (0)
    PK4(p, 0, pa0); PK4(p, 8, pa1);
#undef PK4
}
__device__ __forceinline__ void qk32(f32x16& p, const bf16x8 (&qr)[NQR], ATT_LAS const char* qlds, ATT_LAS const char* Ks, int r32, int hi) {
    p = f32x16{};
    int kl = kswz256(r32, hi * 16); asm volatile("" : "+v"(kl));
#pragma unroll
    for (int d0 = 0; d0 < 8; ++d0) {
        const bf16x8 b0 = *(ATT_LAS const bf16x8*)(Ks + (kl ^ (d0 * 32)));
        const bf16x8 qf = d0 < NQR ? qr[d0 < NQR ? d0 : 0] : *(ATT_LAS const bf16x8*)(qlds + (d0 - NQR) * 1024);
        p = __builtin_amdgcn_mfma_f32_32x32x16_bf16(b0, qf, p, 0, 0, 0); }
}
__device__ __forceinline__ float softmax32(f32x16& p, float& m_reg, float& l_reg, float& m_true) {
    float pmax = fmaxf(fmaxf(p[0], p[1]), p[2]);
#pragma unroll
    for (int r = 3; r < 15; r += 2) pmax = fmaxf(fmaxf(pmax, p[r]), p[r + 1]);
    pmax = half_max(fmaxf(pmax, p[15]));
    m_true = fmaxf(m_true, pmax);
    const float mn = (pmax - m_reg <= THR) ? m_reg : pmax;
    const float alpha = __builtin_amdgcn_exp2f(m_reg - mn);
    m_reg = mn;
    float ps = 0.f;
#pragma unroll
    for (int r = 0; r < 16; ++r) { p[r] = __builtin_amdgcn_exp2f(p[r] - mn); ps += p[r]; }
    l_reg = l_reg * alpha + half_sum(ps);
    return alpha;
}
__device__ __forceinline__ void rescale_o(f32x16 (&o)[8], float alpha, ATT_LAS float* wsf, int r32, int hi) {
    if (__any(alpha < 1.f)) {
        if (hi == 0) wsf[r32] = alpha;
#pragma unroll
        for (int g = 0; g < 4; ++g) {
            const f32x4 a4 = *(ATT_LAS const f32x4*)(wsf + 8 * g + 4 * hi);
#pragma unroll
            for (int j = 0; j < 4; ++j)
#pragma unroll
                for (int d = 0; d < 8; ++d) o[d][4 * g + j] *= a4[j];
        }
    }
}
__device__ __forceinline__ void flash_map(f32x16 (&o)[8], const bf16_t* Qw, const bf16_t* Kb, const bf16_t* Vb, int q0, float slope2, float kmax, ATT_LAS char* lds) {
    const int tid = pg8::otid(), lane = tid & 63, r32 = lane & 31, hi = lane >> 5; const int wid = __builtin_amdgcn_readfirstlane(tid >> 6);
    ATT_LAS float* wsf = (ATT_LAS float*)(lds + FL_WS) + wid * 64;
#pragma unroll
    for (int i = 0; i < 8; ++i) o[i] = f32x16{};
    bf16x8 qr[NQR]; float qss = 0.f;
#pragma unroll
    for (int d0 = 0; d0 < NQR; ++d0) { qr[d0] = *reinterpret_cast<const bf16x8*>(Qw + d0 * 16);
#pragma unroll
        for (int j = 0; j < 8; ++j) { const float x = __uint_as_float((unsigned)(unsigned short)qr[d0][j] << 16); qss += x * x; } }
    ATT_LAS char* qlds = lds + FL_Q + wid * ((8 - NQR) * 1024) + lane * 16;
    float m_reg = NEG_BIG, l_reg = 0.f, m_true = NEG_BIG;
    const int NT = (q0 + 256) / 32;
    const int td = q0 / 32 + wid;
    const int qrel = wid * 32 + r32;
    const unsigned koff = (unsigned)((4 * wid + (lane >> 4)) * PITCH + (((lane & 15) ^ ((4 * wid + (lane >> 4)) & 7)) << 3));
    unsigned voff; { const int kk_ = 8 * (wid >> 1) + ((lane & 31) >> 2), k_ = (kk_ & ~0xC) | ((kk_ & 4) << 1) | ((kk_ & 8) >> 1); voff = (unsigned)(k_ * PITCH + 32 * (2 * (wid & 1) + (lane >> 5)) + 8 * (lane & 3)); }
#define FL_DMA_K(t, kb) do { const bf16_t* kt = Kb + (size_t)(t) * 32 * PITCH + koff; \
        __builtin_amdgcn_global_load_lds((const unsigned*)kt, (ATT_LAS unsigned*)(lds + FL_K + (kb) * FL_KB + wid * 1024), 16, 0, 0); } while (0)
#define FL_DMA_V(t, vbf) do { const bf16_t* vt = Vb + (size_t)(t) * 32 * PITCH + voff; \
        __builtin_amdgcn_global_load_lds((const unsigned*)vt, (ATT_LAS unsigned*)(lds + FL_V + (vbf) * FL_VB + wid * 1024), 16, 0, 0); \
        __builtin_amdgcn_global_load_lds((const unsigned*)(vt + 128), (ATT_LAS unsigned*)(lds + FL_V + (vbf) * FL_VB + 8192 + wid * 1024), 16, 0, 0); } while (0)
    const int vrb = (int)(uintptr_t)(lds + FL_V) + v_rd_base(lane);
    __syncthreads();
#pragma unroll
    for (int d0 = 0; d0 < 8 - NQR; ++d0) { const bf16x8 qf = *reinterpret_cast<const bf16x8*>(Qw + (NQR + d0) * 16); *(ATT_LAS bf16x8*)(qlds + d0 * 1024) = qf;
#pragma unroll
        for (int j = 0; j < 8; ++j) { const float x = __uint_as_float((unsigned)(unsigned short)qf[j] << 16); qss += x * x; } }
    const float bq = sqrtf(half_sum(qss)) * kmax;
    const float tstop = 24.0f - __builtin_amdgcn_logf(1.0f - __builtin_amdgcn_exp2f(-slope2));
#if defined(PROBE_NOPRUNE)
    const float tstop_ = 1e30f;
#define tstop tstop_
#endif
    ATT_LAS int* flg = (ATT_LAS int*)(lds + FL_FLG);
    int sl = (NT - 1) % 3;
    int s1 = (sl + 1) % 3, s2 = (sl + 2) % 3;
    FL_DMA_K(NT - 1, sl); FL_DMA_K(NT - 2, s2); FL_DMA_V(NT - 1, sl);
    asm volatile("s_waitcnt vmcnt(0)" ::: "memory"); __syncthreads();
    bf16x8 pa0, pa1;
#define STEP_TAIL(NFLY) \
        {     \
            const bool ok = (bq - m_true - slope2 * (float)(q0 + qrel - 32 * t + 1) + tstop) <= 0.f; \
            const int mydone = __all(ok) ? 1 : 0; \
            if (lane == 0) flg[(it & 1) * 8 + wid] = mydone; \
        } \
          \
        if (t >= 2) asm volatile("s_waitcnt vmcnt(" #NFLY ") lgkmcnt(0)" ::: "memory"); else asm volatile("s_waitcnt vmcnt(0) lgkmcnt(0)" ::: "memory"); \
        __builtin_amdgcn_s_barrier(); asm volatile("" ::: "memory"); \
        {   typedef int i32x4 __attribute__((ext_vector_type(4))); \
            const i32x4 f0 = *(ATT_LAS const i32x4*)(flg + (it & 1) * 8), f1 = *(ATT_LAS const i32x4*)(flg + (it & 1) * 8 + 4); \
            if ((f0.x & f0.y & f0.z & f0.w & f1.x & f1.y & f1.z & f1.w) != 0) { stopped = true; break; } } \
        { const int o_ = s1; s1 = sl; sl = s2; s2 = o_; }
    bool stopped = false;
    int it = 0;
    if (wid >= 4) __builtin_amdgcn_s_setprio(3);
    for (; it < 8; ++it) {
        const int t = NT - 1 - it;
        if (t >= 1) FL_DMA_V(t - 1, s2);
        if (t >= 2) FL_DMA_K(t - 2, s1);
        if (t <= td) {
            f32x16 p; qk32(p, qr, qlds, lds + FL_K + sl * FL_KB, r32, hi);
            float s2v = slope2; asm volatile("" : "+v"(s2v));
            const float biasbase = s2v * (float)(t * 32 - q0 + 4 * hi - qrel);
            if (t == td) {
#pragma unroll
                for (int r = 0; r < 16; ++r) { const int kr = (r & 3) + 8 * (r >> 2) + 4 * hi; p[r] = (kr > r32) ? -INFINITY : fmaf(s2v, (float)((r & 3) + 8 * (r >> 2)), p[r] + biasbase); }
            } else {
#pragma unroll
                for (int r = 0; r < 16; ++r) p[r] = fmaf(s2v, (float)((r & 3) + 8 * (r >> 2)), p[r] + biasbase);
            }
            const float alpha = softmax32(p, m_reg, l_reg, m_true);
            rescale_o(o, alpha, wsf, r32, hi);
            pack32(p, pa0, pa1);
            const int vbt = vrb + sl * FL_VB;
            PV32_PIPE(o, vbt, (void)0, (void)0, (void)0, (void)0, (void)0, (void)0, (void)0, (void)0);
        }
        STEP_TAIL(1)
    }
    pa0 = bf16x8{}; pa1 = bf16x8{};
    if (!stopped) for (; it < NT; ++it) {
        const int t = NT - 1 - it;
        f32x16 p; qk32(p, qr, qlds, lds + FL_K + sl * FL_KB, r32, hi);
#if defined(PROBE_QK2)
        asm volatile("" : "+v"(p)); qk32(p, qr, qlds, lds + FL_K + sl * FL_KB, r32, hi);
#endif
        if (t >= 1) FL_DMA_V(t - 1, s2);
        if (t >= 2) FL_DMA_K(t - 2, s1);
        float s2v = slope2; asm volatile("" : "+v"(s2v));
        const float biasbase = s2v * (float)(t * 32 - q0 + 4 * hi - qrel);
        const int vbp = vrb + s1 * FL_VB;
        float alpha, pmax, mn, mnb, ps;
#define BIAS(r) p[r] = fmaf(s2v, (float)(((r) & 3) + 8 * ((r) >> 2)), p[r])
#define EXPS(r) do { p[r] = __builtin_amdgcn_exp2f(p[r] - mnb); ps += p[r]; } while (0)
#define VCH1 do { BIAS(0); BIAS(1); BIAS(2); BIAS(3); BIAS(4); BIAS(5); BIAS(6); BIAS(7); } while (0)
#define VCH2 do { BIAS(8); BIAS(9); BIAS(10); BIAS(11); BIAS(12); BIAS(13); BIAS(14); BIAS(15); } while (0)
#define VCH3 do { float a_ = fmaxf(fmaxf(p[0], p[1]), p[2]); float b_ = fmaxf(fmaxf(p[3], p[4]), p[5]); a_ = fmaxf(fmaxf(a_, p[6]), p[7]); b_ = fmaxf(fmaxf(b_, p[8]), p[9]); \
                  a_ = fmaxf(fmaxf(a_, p[10]), p[11]); b_ = fmaxf(fmaxf(b_, p[12]), p[13]); a_ = fmaxf(fmaxf(a_, p[14]), p[15]); pmax = half_max(fmaxf(a_, b_) + biasbase); \
                  m_true = fmaxf(m_true, pmax); mn = (pmax - m_reg <= THR) ? m_reg : pmax; alpha = __builtin_amdgcn_exp2f(m_reg - mn); m_reg = mn; mnb = mn - biasbase; ps = 0.f; } while (0)
#define VCH4 do { EXPS(0); EXPS(1); EXPS(2); EXPS(3); } while (0)
#define VCH5 do { EXPS(4); EXPS(5); EXPS(6); EXPS(7); } while (0)
#define VCH6 do { EXPS(8); EXPS(9); EXPS(10); EXPS(11); } while (0)
#define VCH7 do { EXPS(12); EXPS(13); EXPS(14); EXPS(15); } while (0)
#if defined(PROBE_PV3)
        { PV32_PIPE(o, vbp, (void)0, (void)0, (void)0, (void)0, (void)0, (void)0, (void)0, (void)0);
          const bf16x8 sgn = {(short)0x8000, (short)0x8000, (short)0x8000, (short)0x8000, (short)0x8000, (short)0x8000, (short)0x8000, (short)0x8000};
          pa0 ^= sgn; pa1 ^= sgn; PV32_PIPE(o, vbp, (void)0, (void)0, (void)0, (void)0, (void)0, (void)0, (void)0, (void)0); pa0 ^= sgn; pa1 ^= sgn; }
#endif
        PV32_PIPE(o, vbp, (void)0, VCH1, VCH2, VCH3, VCH4, VCH5, VCH6, VCH7);
#undef VCH1
#undef VCH2
#undef VCH3
#undef VCH4
#undef VCH5
#undef VCH6
#undef VCH7
#undef BIAS
#undef EXPS
        l_reg = l_reg * alpha + half_sum(ps);
        rescale_o(o, alpha, wsf, r32, hi);
        pack32(p, pa0, pa1);
        STEP_TAIL(3)
    }
#undef STEP_TAIL
    __builtin_amdgcn_s_setprio(0);
    asm volatile("s_waitcnt vmcnt(0)" ::: "memory");
    { const int sll = (it < NT) ? sl : s1; const int vbl = vrb + sll * FL_VB;
      PV32_PIPE(o, vbl, (void)0, (void)0, (void)0, (void)0, (void)0, (void)0, (void)0, (void)0); }
#undef FL_DMA_K
#undef FL_DMA_V
    if (hi == 0) wsf[32 + r32] = l_reg;
    asm volatile("s_waitcnt lgkmcnt(0)" ::: "memory");
#pragma unroll
    for (int r = 0; r < 16; ++r) { const float rl = 1.0f / wsf[32 + crow(r, hi)];
#pragma unroll
        for (int d = 0; d < 8; ++d) o[d][r] *= rl; }
}
#undef FPK
#undef RDV32
#undef MMV32
#undef WAITL32
#undef PV32_PIPE

__device__ __forceinline__ void swa_part(const AttnArgs& A, int b, int h, int q0, ATT_LAS char* lds) {
    const int tid = pg8::otid(), lane = tid & 63, r32 = lane & 31, hi = lane >> 5; const int wid = __builtin_amdgcn_readfirstlane(tid >> 6);
    const int kvh = h >> 1;
    const size_t tok0 = (size_t)b * SEQ + q0;
    __syncthreads();
    for (int i = tid; i < 384 * 8; i += 512) {
        const int row = i >> 3, ch = i & 7; const int kpos = q0 - 128 + row;
        bf16x8 kv = bf16x8{}, vv = bf16x8{};
        if (kpos >= 0) { const bf16_t* p = A.proj + ((size_t)b * SEQ + kpos) * PITCH; kv = *reinterpret_cast<const bf16x8*>(p + C_KB + kvh * 64 + ch * 8); vv = *reinterpret_cast<const bf16x8*>(p + C_VB + kvh * 64 + ch * 8); }
        *(ATT_LAS bf16x8*)(lds + SW_K + kswz128(row, ch * 16)) = kv;
        *(ATT_LAS bf16x8*)(lds + SW_V + (row >> 6) * SW_VT + v_st<2>(row & 63, ch * 8)) = vv;
    }
    __syncthreads();
    ATT_LAS float* wsf = (ATT_LAS float*)(lds + FL_WS) + wid * 64;
    const int qrel = wid * 32 + r32;
    const int vrb = (int)(uintptr_t)(lds + SW_V) + v_rd_base(lane);
    for (int hh = 0; hh < 4; ++hh) {
        const int hq = 4 * h + hh;
        const float slope2 = __builtin_amdgcn_exp2f(-0.5f * (float)(hq + 1)) * LOG2E;
        const bf16_t* Qw = A.proj + (tok0 + qrel) * PITCH + C_QB + hq * 64 + hi * 8;
        bf16x8 qr[4];
#pragma unroll
        for (int d0 = 0; d0 < 4; ++d0) qr[d0] = *reinterpret_cast<const bf16x8*>(Qw + d0 * 16);
        float m_reg = A.sinks[hq] * LOG2E, l_reg = 1.0f;
        f32x16 o[2]; o[0] = f32x16{}; o[1] = f32x16{};
        for (int i = 0; i < 3; ++i) {
            const int jt = (wid >> 1) + i;
            f32x16 p0 = f32x16{}, p1 = f32x16{};
            { ATT_LAS const char* Ks = lds + SW_K + jt * 64 * 128;
#pragma unroll
              for (int d0 = 0; d0 < 4; ++d0) { const int cb = (d0 * 16 + hi * 8) * 2;
                  const bf16x8 b0 = *(ATT_LAS const bf16x8*)(Ks + kswz128(r32, cb));
                  const bf16x8 b1 = *(ATT_LAS const bf16x8*)(Ks + kswz128(32 + r32, cb));
                  p0 = __builtin_amdgcn_mfma_f32_32x32x16_bf16(b0, qr[d0], p0, 0, 0, 0);
                  p1 = __builtin_amdgcn_mfma_f32_32x32x16_bf16(b1, qr[d0], p1, 0, 0, 0); } }
            const int krel0 = -128 + 64 * jt + 4 * hi;
#pragma unroll
            for (int r = 0; r < 16; ++r) {
                const int kr = krel0 + (r & 3) + 8 * (r >> 2);
                { const int dist = qrel - kr; const bool ok = (dist >= 0) && (dist < 128) && (q0 + kr >= 0); p0[r] = ok ? p0[r] - slope2 * (float)dist : -INFINITY; }
                { const int dist = qrel - kr - 32; const bool ok = (dist >= 0) && (dist < 128) && (q0 + kr + 32 >= 0); p1[r] = ok ? p1[r] - slope2 * (float)dist : -INFINITY; }
            }
            const float alpha = softmax_step(p0, p1, m_reg, l_reg);
            if (__any(alpha < 1.f)) {
                if (hi == 0) wsf[r32] = alpha;
                asm volatile("s_waitcnt lgkmcnt(0)" ::: "memory");
#pragma unroll
                for (int r = 0; r < 16; ++r) { const float a = wsf[crow(r, hi)]; o[0][r] *= a; o[1][r] *= a; }
            }
            bf16x8 pa0, pa1, pa2, pa3; pack_p(p0, p1, pa0, pa1, pa2, pa3);
            const int vb = vrb + jt * SW_VT;
            pv_one<2, 0>(o[0], vb, pa0, pa1, pa2, pa3); pv_one<2, 1>(o[1], vb, pa0, pa1, pa2, pa3);
        }
        if (hi == 0) wsf[32 + r32] = l_reg;
        asm volatile("s_waitcnt lgkmcnt(0)" ::: "memory");
#pragma unroll
        for (int r = 0; r < 16; ++r) { const int row = wid * 32 + crow(r, hi); const float rl = 1.0f / wsf[32 + crow(r, hi)];
            const bf16_t* gp = A.proj + (tok0 + row) * PITCH + C_GB + hq * 64 + r32; bf16_t* mp = A.merged + (tok0 + row) * DM + hq * 64 + r32;
#pragma unroll
            for (int d = 0; d < 2; ++d) { const float g = __uint_as_float((unsigned)gp[32 * d] << 16); mp[32 * d] = (bf16_t)(cvtpk(o[d][r] * rl * g, 0.f) & 0xffffu); } }
        asm volatile("s_waitcnt lgkmcnt(0)" ::: "memory");
    }
}

__device__ __forceinline__ void flash_item(const AttnArgs& A, int b, int h, int c, int qb, ATT_LAS char* lds) {
    const int tid = pg8::otid(), lane = tid & 63, r32 = lane & 31, hi = lane >> 5; const int wid = __builtin_amdgcn_readfirstlane(tid >> 6);
    const int q0 = qb * 256; const size_t tok0 = (size_t)b * SEQ + q0;
    const float slope2 = __builtin_amdgcn_exp2f(-2.0f * (float)(h + 1)) * LOG2E;
    const bf16_t* Qw = A.proj + (tok0 + wid * 32 + r32) * PITCH + C_QA + h * 256 + c * 128 + hi * 8;
    const bf16_t* Kb = A.proj + (size_t)b * SEQ * PITCH + C_KA + h * 256 + c * 128;
    const bf16_t* Vb = A.proj + (size_t)b * SEQ * PITCH + C_VA + h * 256;
    const float kmax = sqrtf(__uint_as_float(__hip_atomic_load(A.kmax2 + (b * 4 + h) * 2 + c, __ATOMIC_RELAXED, __HIP_MEMORY_SCOPE_AGENT)));
    f32x16 o[8];
    flash_map(o, Qw, Kb, Vb, q0, slope2, kmax, lds);
    bf16_t* op = A.oc + (size_t)c * TOK * DM + (tok0 + wid * 32) * DM + h * 256 + r32;
#pragma unroll
    for (int r = 0; r < 16; ++r)
#pragma unroll
        for (int d = 0; d < 8; ++d) op[(size_t)crow(r, hi) * DM + 32 * d] = (bf16_t)(cvtpk(o[d][r], 0.f) & 0xffffu);
}
#undef SBAR
}

constexpr int NWAVES = 8;
constexpr int PPL = 10;
constexpr int NPHASE = 1 + PPL * DEPTH;
constexpr size_t MiB = 1u << 20;
constexpr size_t al_mib(size_t x) { return (x + MiB - 1) / MiB * MiB; }
constexpr size_t WS_CTL  = 0,                         CTL_ZERO_BYTES = 1 * MiB;
constexpr size_t WS_WIN  = WS_CTL + CTL_ZERO_BYTES,   SZ_WIN  = al_mib((size_t)DEPTH * DIN * DM + (size_t)DEPTH * DIN * 4);
constexpr size_t WS_WO   = WS_WIN + SZ_WIN,           SZ_WO   = al_mib((size_t)DEPTH * DM * DM + (size_t)DEPTH * DM * 4);
constexpr size_t WS_WUP  = WS_WO + SZ_WO,             SZ_WUP  = al_mib((size_t)DEPTH * NEXP * 2 * DFF * DM + (size_t)DEPTH * NEXP * 2 * DFF * 4);
constexpr size_t WS_WDN  = WS_WUP + SZ_WUP,           SZ_WDN  = al_mib((size_t)DEPTH * NEXP * DM * DFF * 2);
constexpr size_t WS_XB   = WS_WDN + SZ_WDN,           SZ_XB   = al_mib((size_t)TOK * DM + (size_t)TOK * 4);
constexpr size_t WS_XF   = WS_XB + SZ_XB,             SZ_XF   = al_mib((size_t)TOK * DM * 4);
constexpr size_t WS_PROJ = WS_XF + SZ_XF,             SZ_PROJ = al_mib((size_t)TOK * DIN * 2);
constexpr size_t WS_MRG  = WS_PROJ + SZ_PROJ,         SZ_MRG  = al_mib((size_t)TOK * DM * 2 + (size_t)TOK * DM + (size_t)TOK * 4);
constexpr size_t WS_MIX  = WS_MRG + SZ_MRG,           SZ_MIX  = al_mib((size_t)TOK * DM * 2);
constexpr size_t WS_HF   = WS_MIX + SZ_MIX,           SZ_HF   = al_mib((size_t)TOK * DM * 4);
constexpr size_t WS_HB   = WS_HF + SZ_HF,             SZ_HB   = al_mib((size_t)TOK * DM + (size_t)TOK * 4 + (size_t)MAXBLK * 256 * 4);
constexpr size_t WS_EID  = WS_HB + SZ_HB,             SZ_EID  = al_mib((size_t)TK * 4);
constexpr size_t WS_GATE = WS_EID + SZ_EID,           SZ_GATE = al_mib((size_t)TK * 4);
constexpr size_t WS_DEST = WS_GATE + SZ_GATE,         SZ_DEST = al_mib((size_t)TK * 4);
constexpr size_t WS_CNT  = WS_DEST + SZ_DEST,         SZ_CNT  = MiB;
constexpr size_t WS_XG   = WS_CNT + SZ_CNT,           SZ_XG   = al_mib((size_t)MAXBLK * 256 * DM * 2);
constexpr size_t WS_ACT  = WS_XG + SZ_XG,             SZ_ACT  = al_mib((size_t)MAXBLK * 256 * DFF * 2);
constexpr size_t WS_Y    = WS_ACT + SZ_ACT,           SZ_Y    = al_mib((size_t)MAXBLK * 256 * DM * 2);
constexpr size_t WS_OSCR = WS_Y + SZ_Y,               SZ_OSCR = al_mib((size_t)2 * TOK * DM * 2);
constexpr size_t WS_END  = WS_OSCR + SZ_OSCR;
constexpr int NCHUNK = TOK / 128;
constexpr int CNT_BLKE = NCHUNK * NEXP, CNT_NBLK = CNT_BLKE + MAXBLK, CNT_TOKL = 16384;
static_assert((CNT_TOKL + MAXBLK * 256) * 4 <= (int)MiB && CNT_NBLK < CNT_TOKL, "CNT region");
constexpr int CW_BAR = 4096;
constexpr int CW_KMAX = 8192;
constexpr int CW_QHEAD = 8448;
constexpr int RING_OFF = 0, RING_BYTES = 158720;
constexpr int LDSCTL_OFF = RING_BYTES, MISC_OFF = LDSCTL_OFF + 320;
constexpr int LDS_BYTES = 163840;
static_assert(att::ATT_LDS <= RING_BYTES, "attention LDS");

#define GAS __attribute__((address_space(1)))
#define LAS __attribute__((address_space(3)))
typedef unsigned short bf16;
typedef unsigned v4u __attribute__((ext_vector_type(4)));
typedef float f32x4 __attribute__((ext_vector_type(4)));
typedef short bf16x8 __attribute__((ext_vector_type(8)));
typedef GAS unsigned gu32;
typedef GAS unsigned long long gu64;
#define RLX_AGENT __ATOMIC_RELAXED, __HIP_MEMORY_SCOPE_AGENT
#define LDS_WAIT() asm volatile("s_waitcnt lgkmcnt(0)" ::: "memory")
#define VM_WAIT() asm volatile("s_waitcnt vmcnt(0)" ::: "memory")
__device__ __forceinline__ unsigned long long rt() { return __builtin_amdgcn_s_memrealtime(); }
__device__ __forceinline__ unsigned f2bf(float f) { unsigned u = __builtin_bit_cast(unsigned, f); return (u + 0x7fffu + ((u >> 16) & 1u)) >> 16; }
__device__ __forceinline__ unsigned pk2(float lo, float hi) { return f2bf(lo) | (f2bf(hi) << 16); }
#define XB_TMO      128
#define XB_XCNT(j)  (256  + 64 * (j))
#define XB_XSUB(j)  (1280 + 64 * (j))
#define XB_XGEN(j)  (2304 + 64 * (j))
#define XB_TOP      3328
#define XB_TOPGEN   3392
#define XCD_BAR_WORDS 3456
#define XB_SPIN_CAP (1u << 18)

__device__ __forceinline__ unsigned xb_ld(unsigned* p)              { return __hip_atomic_load(p, __ATOMIC_RELAXED, __HIP_MEMORY_SCOPE_AGENT); }
__device__ __forceinline__ unsigned xb_add(unsigned* p, unsigned v) { return __hip_atomic_fetch_add(p, v, __ATOMIC_RELAXED, __HIP_MEMORY_SCOPE_AGENT); }
__device__ __forceinline__ unsigned xb_xcc_id() { return (unsigned)__builtin_amdgcn_s_getreg((3 << 11) | 20) & 0xFu; }
#define XB_SPIN(cond, bar) do { unsigned _sp = 0; while (cond) { __builtin_amdgcn_s_sleep(1); \
    if ((++_sp & 255u) == 0u) { if (xb_ld(&(bar)[XB_TMO])) break; if (_sp > XB_SPIN_CAP) { atomicAdd(&(bar)[XB_TMO], 1u); break; } } } } while (0)

struct XcdBarrier {
    unsigned* bar; unsigned x;
    volatile LAS unsigned* st;
};

__device__ __forceinline__ XcdBarrier xcd_barrier_post(unsigned* bar, volatile LAS unsigned* st) {
    XcdBarrier b; b.bar = bar; b.x = xb_xcc_id(); b.st = st;
    if (threadIdx.x == 0) (void)xb_add(&bar[XB_XCNT(b.x)], 1u);
    return b;
}
__device__ __forceinline__ void xcd_barrier_complete(unsigned* bar, unsigned x, unsigned& nloc, unsigned& nx) {
    const unsigned G = gridDim.x * gridDim.y * gridDim.z;
    unsigned sum, cnt, mine, sp = 0u;
    for (;;) {
        sum = 0u; cnt = 0u; mine = 0u;
#pragma unroll
        for (unsigned j = 0; j < 16; ++j) { const unsigned c = xb_ld(&bar[XB_XCNT(j)]); sum += c; cnt += (c > 0u) ? 1u : 0u; mine = (j == x) ? c : mine; }
        if (sum == G) break;
        __builtin_amdgcn_s_sleep(1);
        if ((++sp & 255u) == 0u) { if (xb_ld(&bar[XB_TMO])) break; if (sp > XB_SPIN_CAP) { atomicAdd(&bar[XB_TMO], 1u); break; } }
    }
    nloc = mine > 0u ? mine : 1u; nx = cnt > 0u ? cnt : 1u;
}

__device__ __forceinline__ void xcd_barrier(const XcdBarrier& b) {
    asm volatile("s_waitcnt vmcnt(0)" ::: "memory");
    __syncthreads();
    if (threadIdx.x == 0) {
        unsigned* bar = b.bar;
        __builtin_amdgcn_s_waitcnt(0);
        unsigned nloc = b.st[0], nx = b.st[1];
        if (nloc == 0u) { xcd_barrier_complete(bar, b.x, nloc, nx); b.st[0] = nloc; b.st[1] = nx; }
        const unsigned old = xb_add(&bar[XB_XSUB(b.x)], 1u);
        const unsigned gen = old / nloc;
        if (old + 1u == (gen + 1u) * nloc) {
            __builtin_amdgcn_fence(__ATOMIC_RELEASE, "agent");
            asm volatile("s_waitcnt vmcnt(0)" ::: "memory");
            const unsigned og = xb_add(&bar[XB_TOP], 1u);
            const unsigned tg = og / nx;
            if (og + 1u == (tg + 1u) * nx) xb_add(&bar[XB_TOPGEN], 1u);
            else XB_SPIN(xb_ld(&bar[XB_TOPGEN]) == tg, bar);
            __builtin_amdgcn_fence(__ATOMIC_ACQUIRE, "agent");
            xb_add(&bar[XB_XGEN(b.x)], 1u);
            asm volatile("s_waitcnt vmcnt(0)" ::: "memory");
        } else {
            XB_SPIN(xb_ld(&bar[XB_XGEN(b.x)]) == gen, bar);
            __builtin_amdgcn_fence(__ATOMIC_ACQUIRE, "agent");
            asm volatile("s_waitcnt vmcnt(0)" ::: "memory");
        }
    }
    __syncthreads();
}


#define DPP_F(v_, ctrl_) __int_as_float(__builtin_amdgcn_update_dpp(0, __float_as_int(v_), ctrl_, 0xf, 0xf, true))
__device__ __forceinline__ float wave_sum(float v) {
    v += DPP_F(v, 0xB1); v += DPP_F(v, 0x4E); v += DPP_F(v, 0x124); v += DPP_F(v, 0x128);
    const int b = __float_as_int(v);
    return (__int_as_float(__builtin_amdgcn_readlane(b, 0)) + __int_as_float(__builtin_amdgcn_readlane(b, 16))) + (__int_as_float(__builtin_amdgcn_readlane(b, 32)) + __int_as_float(__builtin_amdgcn_readlane(b, 48)));
}
__device__ __forceinline__ void p0_transpose_item(const float* W, int K, int N, bf16* WT, LAS float* scr, int item, int lane) {
    const int nblk = N / 32, kb = item / nblk, nb = item % nblk, k0 = 64 * kb, n0 = 32 * nb;
    { const int c4 = lane & 7, rsub = lane >> 3;
#pragma unroll
      for (int i = 0; i < 8; ++i) { const int kk = 8 * i + rsub; const f32x4 v = *(const f32x4*)(W + (size_t)(k0 + kk) * N + n0 + 4 * c4);
          scr[kk * 33 + 4 * c4 + 0] = v.x; scr[kk * 33 + 4 * c4 + 1] = v.y; scr[kk * 33 + 4 * c4 + 2] = v.z; scr[kk * 33 + 4 * c4 + 3] = v.w; } }
    LDS_WAIT(); asm volatile("" ::: "memory");
    const int c = lane & 7;
#pragma unroll
    for (int j = 0; j < 4; ++j) { const int n = (lane >> 3) + 8 * j; const LAS float* s = scr + (8 * c) * 33 + n;
        v4u o; o.x = pk2(s[0 * 33], s[1 * 33]); o.y = pk2(s[2 * 33], s[3 * 33]); o.z = pk2(s[4 * 33], s[5 * 33]); o.w = pk2(s[6 * 33], s[7 * 33]);
        *(GAS v4u*)(WT + (size_t)(n0 + n) * K + k0 + 8 * c) = o; }
    LDS_WAIT(); asm volatile("" ::: "memory");
}

__device__ __forceinline__ int q8(float v, float inv) { return (int)__builtin_rintf(fminf(fmaxf(v * inv, -127.f), 127.f)); }
__device__ __forceinline__ unsigned pack4(int a, int b, int c, int d) { return ((unsigned)a & 255u) | (((unsigned)b & 255u) << 8) | (((unsigned)c & 255u) << 16) | ((unsigned)d << 24); }
__device__ __forceinline__ float wave_max(float v) {
    v = fmaxf(v, DPP_F(v, 0xB1)); v = fmaxf(v, DPP_F(v, 0x4E)); v = fmaxf(v, DPP_F(v, 0x124)); v = fmaxf(v, DPP_F(v, 0x128));
    const int b = __float_as_int(v);
    return fmaxf(fmaxf(__int_as_float(__builtin_amdgcn_readlane(b, 0)), __int_as_float(__builtin_amdgcn_readlane(b, 16))), fmaxf(__int_as_float(__builtin_amdgcn_readlane(b, 32)), __int_as_float(__builtin_amdgcn_readlane(b, 48))));
}
__device__ __forceinline__ void quant_row(const f32x4 (&v)[4], signed char* q, float* scale, int lane) {
    float mx = 0.f;
#pragma unroll
    for (int j = 0; j < 4; ++j) mx = fmaxf(fmaxf(fmaxf(mx, fabsf(v[j].x)), fabsf(v[j].y)), fmaxf(fabsf(v[j].z), fabsf(v[j].w)));
    mx = wave_max(mx);
    const float inv = mx > 0.f ? 127.f / mx : 0.f;
#pragma unroll
    for (int j = 0; j < 4; ++j) ((unsigned*)q)[lane + 64 * j] = pack4(q8(v[j].x, inv), q8(v[j].y, inv), q8(v[j].z, inv), q8(v[j].w, inv));
    if (lane == 0) *scale = mx * (1.f / 127.f);
}
struct Args { const float* in[14]; float* out; unsigned char* ws; int g_lo, g_hi; };

__global__ void __launch_bounds__(NWAVES * 64, 2) mk_fwd(Args args) {
    extern __shared__ __attribute__((aligned(16))) unsigned char lds_raw[];
    LAS unsigned char* lds = (LAS unsigned char*)lds_raw;
    volatile LAS unsigned* MISC = (volatile LAS unsigned*)(lds + MISC_OFF);
    const int tid0 = threadIdx.x;
    const int G = gridDim.x; const int vcu = (G % 8 == 0) ? ((int)blockIdx.x % 8) * (G / 8) + (int)blockIdx.x / 8 : (int)blockIdx.x;
    gu32* ctl = (gu32*)(args.ws + WS_CTL);
    for (int u = tid0; u < (LDS_BYTES - LDSCTL_OFF) / 4; u += NWAVES * 64) ((LAS unsigned*)(lds + LDSCTL_OFF))[u] = 0u;
    __syncthreads();
    XcdBarrier bar; bar.bar = (unsigned*)(ctl + CW_BAR); bar.x = 0; bar.st = nullptr;
    if (MK_SINGLE) bar = xcd_barrier_post((unsigned*)(ctl + CW_BAR), MISC + 8);
    const int g_lo = args.g_lo, g_hi = args.g_hi;
#ifndef PH_EN
#define PH_EN 0x7ff
#endif
#ifndef REP_MASK
#define REP_MASK 0
#endif
#define REPS(k) (((REP_MASK >> (k)) & 1) + 1)
#define REP_BEGIN(k) for (int rep_ = 0; rep_ < REPS(k); ++rep_) { if (rep_) xcd_barrier(bar);
#define REP_END() }
#define IN(k) (g_lo <= (k) && (k) < g_hi)
#define BAR_IF(k) do { if (MK_SINGLE && IN(k)) xcd_barrier(bar); } while (0)

#define PHASE_BEGIN() GAS unsigned char* wsg_ = (GAS unsigned char*)args.ws; asm volatile("" : "+s"(wsg_)); unsigned char* ws = (unsigned char*)wsg_;     \
    const int tid = pg8::otid(), lane = tid & 63, wave = __builtin_amdgcn_readfirstlane(tid >> 6); \
    const int gw = vcu * NWAVES + wave, NGW = G * NWAVES; (void)lane; (void)gw; (void)NGW; \
    signed char* WIN_t = (signed char*)(ws + WS_WIN); float* SWIN = (float*)(ws + WS_WIN + (size_t)DEPTH * DIN * DM); signed char* WO_t = (signed char*)(ws + WS_WO); float* SWO = (float*)(ws + WS_WO + (size_t)DEPTH * DM * DM); signed char* WUP_t = (signed char*)(ws + WS_WUP); float* SWUP = (float*)(ws + WS_WUP + (size_t)DEPTH * NEXP * 2 * DFF * DM); bf16* WDN_t = (bf16*)(ws + WS_WDN); \
    signed char* XB = (signed char*)(ws + WS_XB); float* SX = (float*)(ws + WS_XB + (size_t)TOK * DM); float* XF = (float*)(ws + WS_XF); bf16* PROJ = (bf16*)(ws + WS_PROJ); bf16* MRG = (bf16*)(ws + WS_MRG); signed char* MRG8 = (signed char*)(ws + WS_MRG + (size_t)TOK * DM * 2); float* SM = (float*)(ws + WS_MRG + (size_t)TOK * DM * 3); \
    bf16* MIX = (bf16*)(ws + WS_MIX); float* HF = (float*)(ws + WS_HF); signed char* HB = (signed char*)(ws + WS_HB); float* SH = (float*)(ws + WS_HB + (size_t)TOK * DM); float* SHP = SH + TOK; \
    int* EID = (int*)(ws + WS_EID); float* GATE = (float*)(ws + WS_GATE); int* DEST = (int*)(ws + WS_DEST); int* CNT = (int*)(ws + WS_CNT); \
    bf16* XG = (bf16*)(ws + WS_XG); bf16* ACT = (bf16*)(ws + WS_ACT); bf16* Y = (bf16*)(ws + WS_Y); bf16* OSCR = (bf16*)(ws + WS_OSCR); \
    (void)WIN_t; (void)SWO; (void)MRG8; (void)SM; (void)SWIN; (void)SX; (void)SWUP; (void)SH; (void)SHP; (void)WO_t; (void)WUP_t; (void)WDN_t; (void)XB; (void)XF; (void)PROJ; (void)MRG; (void)MIX; (void)HF; (void)HB; (void)EID; (void)GATE; (void)DEST; (void)CNT; (void)XG; (void)ACT; (void)Y; (void)OSCR

    if ((PH_EN & 1) && IN(0)) {
        PHASE_BEGIN();
            REP_BEGIN(0)
        LAS float* scr = (LAS float*)(lds + RING_OFF + wave * 16384);
        for (int m = gw; m < TOK; m += NGW) {
            const GAS f32x4* xr = (const GAS f32x4*)(args.in[0] + (size_t)m * DM) + lane; f32x4 v[4];
#pragma unroll
            for (int j = 0; j < 4; ++j) v[j] = xr[64 * j];
            quant_row(v, XB + (size_t)m * DM, SX + m, lane);
        }
        {
            constexpr int P_IN = DEPTH * (DIN / 32), P_UP = DEPTH * NEXP * (2 * DFF / 32), P_WO = DEPTH * (DM / 32);
            LAS float* P = (LAS float*)(lds + RING_OFF); LAS unsigned* cm = (LAS unsigned*)(lds + RING_OFF + DM * 33 * 4);
            for (int pnl = vcu; pnl < P_IN + P_UP + P_WO; pnl += G) {
                const float* W; int n0, DIN_; signed char* W8; float* SWp;
                if (pnl < P_IN) { const int l = pnl / (DIN / 32); n0 = (pnl % (DIN / 32)) * 32; DIN_ = DIN; W = args.in[1] + (size_t)l * DM * DIN; W8 = WIN_t + (size_t)l * DIN * DM; SWp = SWIN + (size_t)l * DIN; }
                else if (pnl < P_IN + P_UP) { const int q = pnl - P_IN, le = q / (2 * DFF / 32); n0 = (q % (2 * DFF / 32)) * 32; DIN_ = 2 * DFF; W = args.in[10] + (size_t)le * DM * 2 * DFF; W8 = WUP_t + (size_t)le * 2 * DFF * DM; SWp = SWUP + (size_t)le * 2 * DFF; }
                else { const int q = pnl - P_IN - P_UP, lw = q / (DM / 32); n0 = (q % (DM / 32)) * 32; DIN_ = DM; W = args.in[2] + (size_t)lw * DM * DM; W8 = WO_t + (size_t)lw * DM * DM; SWp = SWO + (size_t)lw * DM; }
                __syncthreads();
                if (tid < 32) cm[tid] = 0u;
                const int c4 = tid & 7, r0 = tid >> 3;
                const float* Wc = W + n0 + 4 * c4 + (size_t)r0 * DIN_;
                f32x4 v[16];
#pragma unroll
                for (int i = 0; i < 16; ++i) v[i] = *(const f32x4*)(Wc + (size_t)(64 * i) * DIN_);
                __syncthreads();
                f32x4 mx = {0.f, 0.f, 0.f, 0.f};
#pragma unroll
                for (int i = 0; i < 16; ++i) { LAS float* d = P + (r0 + 64 * i) * 33 + 4 * c4; d[0] = v[i].x; d[1] = v[i].y; d[2] = v[i].z; d[3] = v[i].w;
                    mx.x = fmaxf(mx.x, fabsf(v[i].x)); mx.y = fmaxf(mx.y, fabsf(v[i].y)); mx.z = fmaxf(mx.z, fabsf(v[i].z)); mx.w = fmaxf(mx.w, fabsf(v[i].w)); }
                __hip_atomic_fetch_max(cm + 4 * c4 + 0, __float_as_uint(mx.x), __ATOMIC_RELAXED, __HIP_MEMORY_SCOPE_WORKGROUP); __hip_atomic_fetch_max(cm + 4 * c4 + 1, __float_as_uint(mx.y), __ATOMIC_RELAXED, __HIP_MEMORY_SCOPE_WORKGROUP);
                __hip_atomic_fetch_max(cm + 4 * c4 + 2, __float_as_uint(mx.z), __ATOMIC_RELAXED, __HIP_MEMORY_SCOPE_WORKGROUP); __hip_atomic_fetch_max(cm + 4 * c4 + 3, __float_as_uint(mx.w), __ATOMIC_RELAXED, __HIP_MEMORY_SCOPE_WORKGROUP);
                __syncthreads();
                if (tid < 32) SWp[n0 + tid] = __uint_as_float(cm[tid]) * (1.f / 127.f);
                const int c = lane & 7;
#pragma unroll
                for (int j = 0; j < 2; ++j) { const int k0 = 128 * wave + 64 * j;
#pragma unroll
                    for (int jj = 0; jj < 4; ++jj) { const int n = (lane >> 3) + 8 * jj; const float cmx = __uint_as_float(cm[n]); const float ivn = cmx > 0.f ? 127.f / cmx : 0.f;
                        const LAS float* s = P + (k0 + 8 * c) * 33 + n;
                        const unsigned w0 = pack4(q8(s[0 * 33], ivn), q8(s[1 * 33], ivn), q8(s[2 * 33], ivn), q8(s[3 * 33], ivn)), w1 = pack4(q8(s[4 * 33], ivn), q8(s[5 * 33], ivn), q8(s[6 * 33], ivn), q8(s[7 * 33], ivn));
                        *(GAS unsigned long long*)(W8 + (size_t)(n0 + n) * DM + k0 + 8 * c) = (unsigned long long)w0 | ((unsigned long long)w1 << 32); } }
            }
            __syncthreads();
        }
        {
            constexpr int P_DN = DEPTH * NEXP * (DM / 32);
            for (int pnl = gw; pnl < P_DN; pnl += NGW) {
                const float* W; int n0; bf16* WB;
                { const int le = pnl / (DM / 32); n0 = (pnl % (DM / 32)) * 32; W = args.in[12] + (size_t)le * DFF * DM; WB = WDN_t + (size_t)le * DM * DFF; }
                const int c4 = lane & 7, rsub = lane >> 3;
                const float* Wc = W + n0 + 4 * c4 + (size_t)rsub * DM;
                f32x4 nx[8];
#pragma unroll
                for (int i = 0; i < 8; ++i) nx[i] = *(const f32x4*)(Wc + (size_t)(8 * i) * DM);
                for (int kb = 0; kb < DM / 64; ++kb) { const int k0 = 64 * kb;
#pragma unroll
                    for (int i = 0; i < 8; ++i) { const int kk = 8 * i + rsub; scr[kk * 33 + 4 * c4 + 0] = nx[i].x; scr[kk * 33 + 4 * c4 + 1] = nx[i].y; scr[kk * 33 + 4 * c4 + 2] = nx[i].z; scr[kk * 33 + 4 * c4 + 3] = nx[i].w; }
                    if (kb + 1 < DM / 64) {
#pragma unroll
                        for (int i = 0; i < 8; ++i) nx[i] = *(const f32x4*)(Wc + (size_t)(k0 + 64 + 8 * i) * DM); }
                    LDS_WAIT(); asm volatile("" ::: "memory");
                    const int c = lane & 7;
#pragma unroll
                    for (int jj = 0; jj < 4; ++jj) { const int n = (lane >> 3) + 8 * jj; const LAS float* s = scr + (8 * c) * 33 + n;
                        v4u o; o.x = pk2(s[0 * 33], s[1 * 33]); o.y = pk2(s[2 * 33], s[3 * 33]); o.z = pk2(s[4 * 33], s[5 * 33]); o.w = pk2(s[6 * 33], s[7 * 33]);
                        *(GAS v4u*)(WB + (size_t)(n0 + n) * DM + k0 + 8 * c) = o; }
                    LDS_WAIT(); asm volatile("" ::: "memory"); }
            }
        }
            REP_END()
        BAR_IF(1);
    }

    for (int l = 0; l < DEPTH; ++l) {
        const int pb = 1 + PPL * l;
        if ((PH_EN & 2) && IN(pb + 0)) {
            PHASE_BEGIN();
            REP_BEGIN(1)
            pg8::Gemm g{(const bf16*)XB, (const bf16*)(WIN_t + (size_t)l * DIN * DM), TOK, DIN, DM / 2, 0, nullptr}; pg8::StaticOrder S; S.init(TOK, DIN, G, (int)blockIdx.x, nullptr);
            pg8::EpiInProjI8 E{PROJ, SX, SWIN + (size_t)l * DIN};
            pg8::gemm_phase<pg8::EpiInProjI8, pg8::StaticOrder, true, true, false, true>(lds + RING_OFF, g, S, E);
            REP_END()
            BAR_IF(pb + 1);
        }
        if ((PH_EN & 4) && IN(pb + 1)) {
            PHASE_BEGIN();
            REP_BEGIN(2)
            LAS unsigned* lmax = (LAS unsigned*)(lds + RING_OFF);
            if (tid < 16) lmax[tid] = 0u;
            __syncthreads();
            for (int b = 0; b < NB; ++b) {
                float mx = 0.f;
                for (int m = gw; m < SEQ; m += NGW) {
                    const bf16* kp = PROJ + ((size_t)b * SEQ + m) * DIN + C_KA + lane * 16;
                    const bf16x8 k0 = *(const bf16x8*)kp, k1 = *(const bf16x8*)(kp + 8);
                    float s = 0.f;
#pragma unroll
                    for (int j = 0; j < 8; ++j) { const float x0 = __uint_as_float((unsigned)(unsigned short)k0[j] << 16), x1 = __uint_as_float((unsigned)(unsigned short)k1[j] << 16); s += x0 * x0 + x1 * x1; }
                    s += __shfl_xor(s, 1); s += __shfl_xor(s, 2); s += __shfl_xor(s, 4);
                    mx = fmaxf(mx, s);
                }
                if ((lane & 7) == 0) __hip_atomic_fetch_max(lmax + b * 8 + (lane >> 3), __float_as_uint(mx), __ATOMIC_RELAXED, __HIP_MEMORY_SCOPE_WORKGROUP);
            }
            __syncthreads();
            if (tid < 16) __hip_atomic_fetch_max((unsigned*)(ctl + CW_KMAX + l * 16 + tid), lmax[tid], RLX_AGENT);
            REP_END()
            BAR_IF(pb + 2);
        }
        if ((PH_EN & 8) && IN(pb + 2)) {
            PHASE_BEGIN();
            REP_BEGIN(3)
            att::AttnArgs A; A.proj = PROJ; A.merged = MRG; A.oc = OSCR; A.lam = 0.f; A.one_m_lam_init = 0.f;
            { const float* sg_ = args.in[4] + (size_t)l * 256; const float* sk_ = args.in[5] + (size_t)l * 16; asm volatile("" : "+s"(sg_), "+s"(sk_)); A.subln_g = sg_; A.sinks = sk_; }
            A.kmax2 = (const unsigned*)(ctl + CW_KMAX + l * 16);
            for (;;) {
                __syncthreads();
                if (tid == 0) MISC[12] = __hip_atomic_fetch_add((unsigned*)(ctl + CW_QHEAD + (l * 2 + rep_) * 64), 1u, RLX_AGENT);
                __syncthreads();
                const int n = __builtin_amdgcn_readfirstlane((int)MISC[12]);
                if (n >= 1536) break;
                if (n < 1024) { const int h = 3 - (n >> 8), rem = n & 255; att::flash_item(A, rem & 1, h, (rem >> 1) & 1, 63 - (rem >> 2), (ATT_LAS char*)(lds + RING_OFF)); }
                else { const int m = n - 1024; att::swa_part(A, m & 1, (m >> 1) & 3, (m >> 3) << 8, (ATT_LAS char*)(lds + RING_OFF)); }
            }
            __syncthreads();
            REP_END()
            BAR_IF(pb + 3);
        }
        if ((PH_EN & 16) && IN(pb + 3)) {
            PHASE_BEGIN();
            REP_BEGIN(4)
            const float* lq = args.in[3] + (size_t)l * 4 * 128;
            float d1 = 0.f, d2 = 0.f;
            for (int i = 0; i < 128; ++i) { d1 += lq[i] * lq[128 + i]; d2 += lq[256 + i] * lq[384 + i]; }
            const float lam_init = 0.8f - 0.6f * expf(-0.3f * (float)l);
            const float lam = expf(d1) - expf(d2) + lam_init;
            const f32x4 gs = *((const f32x4*)(args.in[4] + (size_t)l * 256) + lane) * (1.0f - lam_init);
            const bf16* OC0 = OSCR; const bf16* OC1 = OSCR + (size_t)TOK * DM;
#define BF4(w) ((f32x4){__uint_as_float((unsigned)((w) & 0xffffu) << 16), __uint_as_float((unsigned)(((w) >> 16) & 0xffffu) << 16), __uint_as_float((unsigned)(((w) >> 32) & 0xffffu) << 16), __uint_as_float((unsigned)((w) >> 48) << 16)})
#define CB_LOAD(o0_, o1_, ga_, sw_, m_) do { _Pragma("unroll") for (int j = 0; j < 4; ++j) { o0_[j] = *((const unsigned long long*)(OC0 + (size_t)(m_) * DM) + lane + 64 * j); o1_[j] = *((const unsigned long long*)(OC1 + (size_t)(m_) * DM) + lane + 64 * j); \
                ga_[j] = *((const unsigned long long*)(PROJ + (size_t)(m_) * DIN + C_GA) + lane + 64 * j); sw_[j] = *((const unsigned long long*)(MRG + (size_t)(m_) * DM) + lane + 64 * j); } } while (0)
            if (gw < TOK) {
                int m = gw; unsigned long long oa0[4], oa1[4], gaa[4], swa[4];
                CB_LOAD(oa0, oa1, gaa, swa, m);
                for (; m < TOK; m += NGW) {
                    const int mn = (m + NGW < TOK) ? m + NGW : m;
                    unsigned long long on0[4], on1[4], gan[4], swn[4];
                    CB_LOAD(on0, on1, gan, swn, mn);
                    f32x4 d[4]; float ss[4];
#pragma unroll
                    for (int j = 0; j < 4; ++j) { const f32x4 a0 = BF4(oa0[j]), a1 = BF4(oa1[j]);
                        d[j] = a0 - a1 * lam; ss[j] = (d[j].x * d[j].x + d[j].y * d[j].y) + (d[j].z * d[j].z + d[j].w * d[j].w); }
#pragma unroll
                    for (int j = 0; j < 4; ++j) ss[j] = wave_sum(ss[j]);
#pragma unroll
                    for (int j = 0; j < 4; ++j) { const float rstd = 1.0f / sqrtf(ss[j] * (1.0f / 256.0f) + LN_EPS);
                        const f32x4 g4 = BF4(gaa[j]), s4 = BF4(swa[j]);
                        const f32x4 v = d[j] * rstd * gs;
                        d[j] = (f32x4){v.x * g4.x + s4.x, v.y * g4.y + s4.y, v.z * g4.z + s4.z, v.w * g4.w + s4.w}; }
                    quant_row(d, MRG8 + (size_t)m * DM, SM + m, lane);
#pragma unroll
                    for (int j = 0; j < 4; ++j) { oa0[j] = on0[j]; oa1[j] = on1[j]; gaa[j] = gan[j]; swa[j] = swn[j]; }
                }
            }
#undef CB_LOAD
#undef BF4
            REP_END()
            BAR_IF(pb + 4);
        }
        if ((PH_EN & 32) && IN(pb + 4)) {
            PHASE_BEGIN();
            REP_BEGIN(5)
            pg8::Gemm g{(const bf16*)MRG8, (const bf16*)(WO_t + (size_t)l * DM * DM), TOK, DM, DM / 2, 0, nullptr}; pg8::StaticOrder S; S.init(TOK, DM, G, (int)blockIdx.x, nullptr);
            pg8::EpiBf16I8 E{MIX, DM, SM, SWO + (size_t)l * DM};
            pg8::gemm_phase<pg8::EpiBf16I8, pg8::StaticOrder, true, true, false, true>(lds + RING_OFF, g, S, E);
            REP_END()
            BAR_IF(pb + 5);
        }
        if ((PH_EN & 64) && IN(pb + 5)) {
            PHASE_BEGIN();
            REP_BEGIN(6)
            const float* xin = (l == 0) ? args.in[0] : XF;
            const float* lg_ = args.in[6] + (size_t)(l * 2 + 0) * DM; const float* lb_ = args.in[7] + (size_t)(l * 2 + 0) * DM;
            const float* WR = args.in[8] + (size_t)l * DM * NEXP; const float* BR = args.in[9] + (size_t)l * NEXP;
            constexpr int WT_LD = DM + 4;
            LAS float* Wt = (LAS float*)(lds + RING_OFF); LAS int* lcnt = (LAS int*)(lds + RING_OFF + NEXP * WT_LD * 4);
#pragma unroll 4
            for (int it = 0; it < 16; ++it) { const int k = tid + 512 * (it >> 3), e4 = it & 7; const f32x4 wv = *(const f32x4*)(WR + (size_t)k * NEXP + 4 * e4);
                Wt[(4 * e4 + 0) * WT_LD + k] = wv.x; Wt[(4 * e4 + 1) * WT_LD + k] = wv.y; Wt[(4 * e4 + 2) * WT_LD + k] = wv.z; Wt[(4 * e4 + 3) * WT_LD + k] = wv.w; }
            f32x4 gv[4], bv[4];
#pragma unroll
            for (int j = 0; j < 4; ++j) { gv[j] = *((const f32x4*)lg_ + lane + 64 * j); bv[j] = *((const f32x4*)lb_ + lane + 64 * j); }
            for (int chunk = blockIdx.x; chunk < NCHUNK; chunk += G) {
                if (tid < NEXP) lcnt[tid] = 0;
                __syncthreads();
                const size_t row0 = (size_t)chunk * 128 + wave * 16;
                f32x4 xa[4]; unsigned long long ma[4];
                { const f32x4* xr = (const f32x4*)(xin + row0 * DM) + lane; const unsigned long long* mr = (const unsigned long long*)(MIX + row0 * DM) + lane;
#pragma unroll
                  for (int j = 0; j < 4; ++j) { xa[j] = xr[64 * j]; ma[j] = mr[64 * j]; } }
#pragma unroll 2
                for (int i = 0; i < 16; ++i) {
                    const size_t row = row0 + i; const size_t rown = row0 + (i < 15 ? i + 1 : i);
                    f32x4 xn[4]; unsigned long long mn[4];
                    { const f32x4* xr = (const f32x4*)(xin + rown * DM) + lane; const unsigned long long* mr = (const unsigned long long*)(MIX + rown * DM) + lane;
#pragma unroll
                      for (int j = 0; j < 4; ++j) { xn[j] = xr[64 * j]; mn[j] = mr[64 * j]; } }
                    f32x4 v[4]; float s = 0.f;
#pragma unroll
                    for (int j = 0; j < 4; ++j) { const unsigned long long mw = ma[j];
                        const f32x4 mv = {__uint_as_float((unsigned)(mw & 0xffffu) << 16), __uint_as_float((unsigned)((mw >> 16) & 0xffffu) << 16), __uint_as_float((unsigned)((mw >> 32) & 0xffffu) << 16), __uint_as_float((unsigned)(mw >> 48) << 16)};
                        v[j] = xa[j] * DN_ALPHA + mv; s += (v[j].x + v[j].y) + (v[j].z + v[j].w); }
                    const float mean = wave_sum(s) * (1.f / DM); float s2 = 0.f;
#pragma unroll
                    for (int j = 0; j < 4; ++j) { v[j] = v[j] - mean; s2 += (v[j].x * v[j].x + v[j].y * v[j].y) + (v[j].z * v[j].z + v[j].w * v[j].w); }
                    const float rstd = 1.f / sqrtf(wave_sum(s2) * (1.f / DM) + LN_EPS);
                    f32x4* hr = (f32x4*)(HF + row * DM) + lane;
#pragma unroll
                    for (int j = 0; j < 4; ++j) { v[j] = v[j] * rstd * gv[j] + bv[j]; hr[64 * j] = v[j]; }
                    quant_row(v, HB + row * DM, SH + row, lane);
#pragma unroll
                    for (int j = 0; j < 4; ++j) { xa[j] = xn[j]; ma[j] = mn[j]; }
                }
                VM_WAIT();
                {
                    const int c16 = lane & 15, kq = lane >> 4;
                    const float* hrow = HF + (row0 + c16) * DM + 4 * kq; const LAS float* w0 = Wt + c16 * WT_LD + 4 * kq; const LAS float* w1 = w0 + 16 * WT_LD;
                    f32x4 acc0 = {0.f, 0.f, 0.f, 0.f}, acc1 = {0.f, 0.f, 0.f, 0.f};
                    f32x4 hq[8], aq0[2], aq1[2];
#pragma unroll
                    for (int p = 0; p < 8; ++p) hq[p] = *(const f32x4*)(hrow + 16 * p);
#pragma unroll
                    for (int p = 0; p < 2; ++p) { aq0[p] = *(const LAS f32x4*)(w0 + 16 * p); aq1[p] = *(const LAS f32x4*)(w1 + 16 * p); }
#pragma unroll 1
                    for (int s8 = 0; s8 < 64; s8 += 8) {
#pragma unroll
                        for (int p = 0; p < 8; ++p) {
                            const f32x4 hv = hq[p], a0 = aq0[p & 1], a1 = aq1[p & 1];
                            const int sh = (s8 + 8 + p) & 63, sa = (s8 + 2 + p) & 63;
                            hq[p] = *(const f32x4*)(hrow + 16 * sh); aq0[p & 1] = *(const LAS f32x4*)(w0 + 16 * sa); aq1[p & 1] = *(const LAS f32x4*)(w1 + 16 * sa);
                            __builtin_amdgcn_sched_barrier(0);
#pragma unroll
                            for (int j = 0; j < 4; ++j) { acc0 = __builtin_amdgcn_mfma_f32_16x16x4f32(a0[j], hv[j], acc0, 0, 0, 0); acc1 = __builtin_amdgcn_mfma_f32_16x16x4f32(a1[j], hv[j], acc1, 0, 0, 0); }
                            __builtin_amdgcn_sched_barrier(0);
                        }
                    }
                    float lg[32];
#pragma unroll
                    for (int q = 0; q < 4; ++q)
#pragma unroll
                        for (int r = 0; r < 4; ++r) { lg[4 * q + r] = __shfl(acc0[r], c16 + 16 * q); lg[16 + 4 * q + r] = __shfl(acc1[r], c16 + 16 * q); }
#pragma unroll
                    for (int e = 0; e < 32; ++e) lg[e] += BR[e];
                    int ei[4]; float ev[4];
#pragma unroll
                    for (int k = 0; k < 4; ++k) { float best = -INFINITY; int bi = 0;
#pragma unroll
                        for (int e = 0; e < 32; ++e) if (lg[e] > best) { best = lg[e]; bi = e; }
                        ev[k] = best; ei[k] = bi;
#pragma unroll
                        for (int e = 0; e < 32; ++e) lg[e] = (e == bi) ? -INFINITY : lg[e]; }
                    float w[4], wsum = 0.f;
#pragma unroll
                    for (int k = 0; k < 4; ++k) { w[k] = __builtin_amdgcn_exp2f((ev[k] - ev[0]) * LOG2E); wsum += w[k]; }
                    const float rs = 1.0f / wsum;
                    if (kq == 0) {
                        typedef int i32x4 __attribute__((ext_vector_type(4)));
                        *(i32x4*)(EID + (row0 + c16) * 4) = (i32x4){ei[0], ei[1], ei[2], ei[3]};
                        *(f32x4*)(GATE + (row0 + c16) * 4) = (f32x4){w[0] * rs, w[1] * rs, w[2] * rs, w[3] * rs};
#pragma unroll
                        for (int k = 0; k < 4; ++k) __hip_atomic_fetch_add(lcnt + ei[k], 1, __ATOMIC_RELAXED, __HIP_MEMORY_SCOPE_WORKGROUP);
                    }
                }
                __syncthreads();
                if (tid < NEXP) CNT[chunk * NEXP + tid] = lcnt[tid];
            }
            REP_END()
            BAR_IF(pb + 6);
        }
        if ((PH_EN & 128) && IN(pb + 6)) {
            PHASE_BEGIN();
            REP_BEGIN(7)
            LAS int* stot = (LAS int*)(lds + RING_OFF); LAS int* spre = stot + 512; LAS int* ltot = spre + 512; LAS int* lpre = ltot + 32; LAS int* lstart = lpre + 32;
            LAS int* lbase = lstart + 32; LAS int* lnb = lbase + 32; LAS int* ldest = lnb + 32;
            for (int chunk = blockIdx.x; chunk < NCHUNK; chunk += G) {
                { const int e = tid & 31, part = tid >> 5; int tot = 0, pre = 0;
                  for (int c = part * 16; c < part * 16 + 16; ++c) { const int v = CNT[c * NEXP + e]; tot += v; pre += (c < chunk) ? v : 0; }
                  stot[part * 32 + e] = tot; spre[part * 32 + e] = pre; }
                __syncthreads();
                if (tid < 32) { int tot = 0, pre = 0; for (int p = 0; p < 16; ++p) { tot += stot[p * 32 + tid]; pre += spre[p * 32 + tid]; } ltot[tid] = tot; lpre[tid] = pre; }
                __syncthreads();
                if (tid == 0) { int a = 0; for (int e = 0; e < 32; ++e) { lstart[e] = a; a += (ltot[e] + 255) & ~255; } lnb[0] = a >> 8; }
                __syncthreads();
                if (tid < 32) lbase[tid] = lstart[tid] + lpre[tid];
                if (chunk == 0) {
                    for (int blk = tid; blk < MAXBLK; blk += 512) { int e = 31; for (int q = 31; q >= 0; --q) if (blk * 256 < lstart[q] + ((ltot[q] + 255) & ~255)) e = q; CNT[CNT_BLKE + blk] = e; }
                    if (tid == 0) CNT[CNT_NBLK] = lnb[0];
                }
                __syncthreads();
                { const size_t t = (size_t)chunk * 128 + (tid >> 2); const int k = tid & 3; const int e = EID[t * 4 + k];
                  const int pos = __hip_atomic_fetch_add(lbase + e, 1, __ATOMIC_RELAXED, __HIP_MEMORY_SCOPE_WORKGROUP); DEST[t * 4 + k] = pos; ldest[tid] = pos; }
                __syncthreads();
                CNT[CNT_TOKL + ldest[tid]] = chunk * 128 + (tid >> 2);
                SHP[ldest[tid]] = SH[chunk * 128 + (tid >> 2)];
                if (chunk < NEXP) { const int e = chunk; const int r0 = lstart[e] + ltot[e], r1 = lstart[e] + ((ltot[e] + 255) & ~255);
                    for (int i = r0 + tid; i < r1; i += 512) { CNT[CNT_TOKL + i] = 0; SHP[i] = 0.f; } }
                __syncthreads();
            }
            REP_END()
            BAR_IF(pb + 7);
        }
        if ((PH_EN & 256) && IN(pb + 7)) {
            PHASE_BEGIN();
            REP_BEGIN(8)
            const int nblk = __builtin_amdgcn_readfirstlane(__hip_atomic_load(CNT + CNT_NBLK, RLX_AGENT));
            pg8::Gemm g{(const bf16*)HB, (const bf16*)(WUP_t + (size_t)l * NEXP * 2 * DFF * DM), nblk * 256, 2 * DFF, DM / 2, (size_t)2 * DFF * DM, CNT + CNT_TOKL}; pg8::StaticOrder S; S.init(nblk * 256, 2 * DFF, G, (int)blockIdx.x, CNT + CNT_BLKE);
            pg8::EpiSwiGLUI8 E{ACT, args.in[11] + (size_t)l * NEXP * 2 * DFF, SHP, SWUP + (size_t)l * NEXP * 2 * DFF};
            pg8::gemm_phase<pg8::EpiSwiGLUI8, pg8::StaticOrder, true, true, true, true>(lds + RING_OFF, g, S, E);
            REP_END()
            BAR_IF(pb + 8);
        }
        if ((PH_EN & 512) && IN(pb + 8)) {
            PHASE_BEGIN();
            REP_BEGIN(9)
            const int nblk = __builtin_amdgcn_readfirstlane(__hip_atomic_load(CNT + CNT_NBLK, RLX_AGENT));
            pg8::Gemm g{ACT, WDN_t + (size_t)l * NEXP * DM * DFF, nblk * 256, DM, DFF, (size_t)DM * DFF * 2, nullptr}; pg8::StaticOrder S; S.init(nblk * 256, DM, G, (int)blockIdx.x, CNT + CNT_BLKE);
            pg8::EpiBf16Bias E{Y, DM, args.in[13] + (size_t)l * NEXP * DM, DM};
            pg8::gemm_phase<pg8::EpiBf16Bias, pg8::StaticOrder, true, true>(lds + RING_OFF, g, S, E);
            REP_END()
            BAR_IF(pb + 9);
        }
        if ((PH_EN & 1024) && IN(pb + 9)) {
            PHASE_BEGIN();
            REP_BEGIN(10)
            const float* lg_ = args.in[6] + (size_t)(l * 2 + 1) * DM; const float* lb_ = args.in[7] + (size_t)(l * 2 + 1) * DM;
            float* xo = (l == DEPTH - 1) ? args.out : XF;
            f32x4 gv[4], bv[4];
#pragma unroll
            for (int j = 0; j < 4; ++j) { gv[j] = *((const f32x4*)lg_ + lane + 64 * j); bv[j] = *((const f32x4*)lb_ + lane + 64 * j); }
            typedef int i32x4 __attribute__((ext_vector_type(4)));
#define BF4(w) ((f32x4){__uint_as_float((unsigned)((w) & 0xffffu) << 16), __uint_as_float((unsigned)(((w) >> 16) & 0xffffu) << 16), __uint_as_float((unsigned)(((w) >> 32) & 0xffffu) << 16), __uint_as_float((unsigned)((w) >> 48) << 16)})
#define T3_LOAD(h_, y_, m_, dd_) do { const f32x4* hr_ = (const f32x4*)(HF + (size_t)(m_) * DM) + lane; \
                const unsigned long long* y0_ = (const unsigned long long*)(Y + (size_t)(dd_).x * DM) + lane; const unsigned long long* y1_ = (const unsigned long long*)(Y + (size_t)(dd_).y * DM) + lane; \
                const unsigned long long* y2_ = (const unsigned long long*)(Y + (size_t)(dd_).z * DM) + lane; const unsigned long long* y3_ = (const unsigned long long*)(Y + (size_t)(dd_).w * DM) + lane; \
                _Pragma("unroll") for (int j = 0; j < 4; ++j) { h_[j] = hr_[64 * j]; y_[0][j] = y0_[64 * j]; y_[1][j] = y1_[64 * j]; y_[2][j] = y2_[64 * j]; y_[3][j] = y3_[64 * j]; } } while (0)
            if (gw < TOK) {
                int m = gw; int m1 = (m + NGW < TOK) ? m + NGW : m;
                i32x4 dd = *(const i32x4*)(DEST + (size_t)m * 4); f32x4 gg = *(const f32x4*)(GATE + (size_t)m * 4);
                i32x4 dd1 = *(const i32x4*)(DEST + (size_t)m1 * 4); f32x4 gg1 = *(const f32x4*)(GATE + (size_t)m1 * 4);
                f32x4 ha[4]; unsigned long long ya[4][4];
                T3_LOAD(ha, ya, m, dd);
                for (; m < TOK; m += NGW) {
                    f32x4 hn[4]; unsigned long long yn[4][4];
                    T3_LOAD(hn, yn, m1, dd1);
                    const int m2 = (m1 + NGW < TOK) ? m1 + NGW : m1;
                    const i32x4 dd2 = *(const i32x4*)(DEST + (size_t)m2 * 4); const f32x4 gg2 = *(const f32x4*)(GATE + (size_t)m2 * 4);
                    f32x4 v[4]; float s = 0.f;
#pragma unroll
                    for (int j = 0; j < 4; ++j) { v[j] = ha[j] * DN_ALPHA + (BF4(ya[0][j]) * gg.x + BF4(ya[1][j]) * gg.y + BF4(ya[2][j]) * gg.z + BF4(ya[3][j]) * gg.w); s += (v[j].x + v[j].y) + (v[j].z + v[j].w); }
                    const float mean = wave_sum(s) * (1.f / DM); float s2 = 0.f;
#pragma unroll
                    for (int j = 0; j < 4; ++j) { v[j] = v[j] - mean; s2 += (v[j].x * v[j].x + v[j].y * v[j].y) + (v[j].z * v[j].z + v[j].w * v[j].w); }
                    const float rstd = 1.f / sqrtf(wave_sum(s2) * (1.f / DM) + LN_EPS);
                    f32x4* xr = (f32x4*)(xo + (size_t)m * DM) + lane;
#pragma unroll
                    for (int j = 0; j < 4; ++j) { v[j] = v[j] * rstd * gv[j] + bv[j]; xr[64 * j] = v[j]; }
                    if (l + 1 < DEPTH) quant_row(v, XB + (size_t)m * DM, SX + m, lane);
#pragma unroll
                    for (int j = 0; j < 4; ++j) { ha[j] = hn[j]; ya[0][j] = yn[0][j]; ya[1][j] = yn[1][j]; ya[2][j] = yn[2][j]; ya[3][j] = yn[3][j]; }
                    gg = gg1; gg1 = gg2; dd1 = dd2; m1 = m2;
                }
            }
#undef T3_LOAD
#undef BF4
            REP_END()
            BAR_IF(pb + 10);
        }
    }
#undef IN
#undef BAR_IF
}

extern "C" void kernel_launch(void* const* d_in, const int* in_sizes, int n_in, void* d_out, int out_size, void* d_ws, size_t ws_size, hipStream_t stream) {
    static int grid = 0;
    if (grid == 0) {
        if (n_in != 14 || in_sizes[0] != TOK * DM || out_size != TOK * DM || ws_size < WS_END) { fprintf(stderr, "kernel_launch: shape/workspace mismatch (n_in %d, in0 %d, out %d, ws %zu, need %zu)\n", n_in, n_in > 0 ? in_sizes[0] : -1, out_size, ws_size, (size_t)WS_END); grid = -1; return; }
        int dev = 0, cus = 0, per_cu = 0;
        if (hipGetDevice(&dev) != hipSuccess || hipDeviceGetAttribute(&cus, hipDeviceAttributeMultiprocessorCount, dev) != hipSuccess) { grid = -1; return; }
        if (hipFuncSetAttribute((const void*)mk_fwd, hipFuncAttributeMaxDynamicSharedMemorySize, LDS_BYTES) != hipSuccess) { fprintf(stderr, "kernel_launch: hipFuncSetAttribute failed\n"); grid = -1; return; }
        if (hipOccupancyMaxActiveBlocksPerMultiprocessor(&per_cu, (const void*)mk_fwd, NWAVES * 64, LDS_BYTES) != hipSuccess || per_cu < 1) fprintf(stderr, "kernel_launch: occupancy query reports %d\n", per_cu);
        (void)hipGetLastError();
        grid = cus > 256 ? 256 : cus;
    }
    if (grid < 0) return;
    if (hipMemsetAsync((char*)d_ws + WS_CTL, 0, CTL_ZERO_BYTES, stream) != hipSuccess) return;
    Args a{};
    for (int i = 0; i < 14; ++i) a.in[i] = (const float*)d_in[i];
    a.out = (float*)d_out; a.ws = (unsigned char*)d_ws;
#if MK_SINGLE
    a.g_lo = 0; a.g_hi = NPHASE;
    hipLaunchKernelGGL(mk_fwd, dim3(grid), dim3(NWAVES * 64), LDS_BYTES, stream, a);
#else
    for (int g = 0; g < NPHASE; ++g) { a.g_lo = g; a.g_hi = g + 1; hipLaunchKernelGGL(mk_fwd, dim3(grid), dim3(NWAVES * 64), LDS_BYTES, stream, a); }
#endif
    const hipError_t le = hipPeekAtLastError();
    if (le != hipSuccess) fprintf(stderr, "kernel_launch: launch failed: %s\n", hipGetErrorName(le));
}
```

```cpp
#include <hip/hip_runtime.h>
#include <cstdio>
#include <cstdint>

#ifndef MK_SINGLE
#define MK_SINGLE 1
#endif

constexpr int NB = 2, SEQ = 16384, DM = 1024, DEPTH = 4, TOK = NB * SEQ;
constexpr int DIN = 6400, NEXP = 32, TOPK = 4, DFF = 1024, TK = TOK * TOPK;
constexpr int C_QA = 0, C_KA = 1024, C_VA = 2048, C_QB = 3072, C_KB = 4096, C_VB = 4224, C_GA = 4352, C_GB = 5376;
constexpr int MAXBLK = 544;
constexpr float LN_EPS = 1e-5f;
constexpr float DN_ALPHA = 1.6817928305074290f;
constexpr float LOG2E = 1.4426950408889634f;
constexpr float QA_SCALE = 0.08838834764831845f * LOG2E;
constexpr float QB_SCALE = 0.125f * LOG2E;
constexpr float SW_LIMIT = 7.0f, SW_ALPHA = 1.702f;

namespace pg8 {
#define PG8_LAS __attribute__((address_space(3)))
typedef unsigned short bf16_t;
typedef short bf16x8 __attribute__((ext_vector_type(8)));
typedef float f32x4 __attribute__((ext_vector_type(4)));
typedef float f32x2 __attribute__((ext_vector_type(2)));
typedef unsigned u32x4 __attribute__((ext_vector_type(4)));
typedef unsigned u32x2 __attribute__((ext_vector_type(2)));
typedef int i32x4 __attribute__((ext_vector_type(4)));
constexpr int BM = 256, BK = 64, HALF = 128, HTB = HALF * BK * 2  , STAGE_BYTES = 8 * HTB, NXCD = 8, WGM = 8;

__host__ __device__ __forceinline__ int lds_byte(int r, int c) { const int st = (r >> 4) * 2 + (c >> 5), rr = r & 15, cc = c & 31, ob = rr * 64 + cc * 2; return st * 1024 + (ob ^ (((ob >> 9) & 1) << 5)); }
__host__ __device__ __forceinline__ void stage_rc(int b, int& R, int& C) { const int st = b / 1024, sb = b % 1024, swz = sb ^ (((sb >> 9) & 1) << 5); R = (st >> 1) * 16 + swz / 64; C = (st & 1) * 32 + (swz % 64) / 2; }
__host__ __device__ __forceinline__ int perm32(int rho) { const int n = rho >> 4, i = rho & 15; return 8 * (i >> 2) + 4 * n + (i & 3); }

struct Unit { int pm, pn, e; };
struct Gemm { const bf16_t* A; const bf16_t* Bt; int M, N, K; size_t bstride; const int* rowidx; };

struct StaticOrder {
    int nM, nN, nwg, G, c; const int* blke;
    __device__ void init(int M, int N, int G_, int c_, const int* blke_) { nM = M / BM; nN = N / BM; nwg = nM * nN; G = G_; c = c_; blke = blke_; }
    __device__ bool next(int i, Unit& u) const {
        const long L = (long)i * G + c; if (L >= nwg) return false;
        int wgid = (int)L; { const int q = nwg / NXCD, r = nwg % NXCD, xcd = wgid % NXCD, off = wgid / NXCD; wgid = (xcd < r ? xcd * (q + 1) : r * (q + 1) + (xcd - r) * q) + off; }
        const int nig = WGM * nN, gid = wgid / nig, fm = gid * WGM, gsz = (nM - fm) < WGM ? (nM - fm) : WGM;
        u.pm = fm + ((wgid % nig) % gsz); u.pn = (wgid % nig) / gsz;
        u.e = blke ? __builtin_amdgcn_readfirstlane(__hip_atomic_load(blke + u.pm, __ATOMIC_RELAXED, __HIP_MEMORY_SCOPE_AGENT)) : 0;
        return true;
    }
    __device__ __forceinline__ void a_ready(const Unit&) const {}
    __device__ __forceinline__ void done(const Unit&) const {}
};

__device__ __forceinline__ int otid() { int t = threadIdx.x; asm volatile("" : "+v"(t)); return t; }
__device__ __forceinline__ unsigned cvt_pk_bf16(float lo, float hi) { unsigned r; asm volatile("v_cvt_pk_bf16_f32 %0, %1, %2" : "=v"(r) : "v"(lo), "v"(hi)); return r; }
__device__ __forceinline__ float fast_sigmoid(float x) { return __builtin_amdgcn_rcpf(1.0f + __builtin_amdgcn_exp2f(-x * 1.4426950408889634f)); }

struct EpiInProj {
    static constexpr bool PERM = true, AFTER_DRAIN = false;
    bf16_t* O;
    __device__ __forceinline__ void operator()(const f32x4 (&acc)[2][2][4][2], const Unit& u, int wr, int wc, int fr, int fq) const {
        const int row0 = u.pm * BM + wr * 64 + fr, col0 = u.pn * BM + wc * 32 + 8 * fq;
        const int pn = u.pn;
        const float sc = (pn < 4) ? QA_SCALE : ((pn >= 12 && pn < 16) ? QB_SCALE : 1.0f);
        const bool sig = pn >= 17;
#pragma unroll
        for (int ai = 0; ai < 2; ++ai)
#pragma unroll
            for (int m = 0; m < 4; ++m) { bf16_t* rowp = O + (size_t)(row0 + ai * HALF + m * 16) * DIN + col0;
#pragma unroll
                for (int bj = 0; bj < 2; ++bj) { f32x4 v0 = acc[ai][bj][m][0] * sc, v1 = acc[ai][bj][m][1] * sc;
                    if (sig) {
#pragma unroll
                        for (int q = 0; q < 4; ++q) { v0[q] = fast_sigmoid(v0[q]); v1[q] = fast_sigmoid(v1[q]); } }
                    u32x4 w; w.x = cvt_pk_bf16(v0[0], v0[1]); w.y = cvt_pk_bf16(v0[2], v0[3]); w.z = cvt_pk_bf16(v1[0], v1[1]); w.w = cvt_pk_bf16(v1[2], v1[3]);
                    *(u32x4*)(rowp + bj * HALF) = w; } }
    }
};
struct EpiInProjI8 {
    static constexpr bool PERM = true, AFTER_DRAIN = false;
    bf16_t* O; const float* sx; const float* sw;
    __device__ __forceinline__ void operator()(const f32x4 (&acc)[2][2][4][2], const Unit& u, int wr, int wc, int fr, int fq) const {
        const int row0 = u.pm * BM + wr * 64 + fr, col0 = u.pn * BM + wc * 32 + 8 * fq;
        const int pn = u.pn;
        const float sc = (pn < 4) ? QA_SCALE : ((pn >= 12 && pn < 16) ? QB_SCALE : 1.0f);
        const bool sig = pn >= 17;
        f32x4 cw[2][2];
#pragma unroll
        for (int bj = 0; bj < 2; ++bj)
#pragma unroll
            for (int n = 0; n < 2; ++n) cw[bj][n] = *(const f32x4*)(sw + col0 + bj * HALF + 4 * n) * sc;
#pragma unroll
        for (int ai = 0; ai < 2; ++ai)
#pragma unroll
            for (int m = 0; m < 4; ++m) { const int row = row0 + ai * HALF + m * 16; const float rs = sx[row]; bf16_t* rowp = O + (size_t)row * DIN + col0;
#pragma unroll
                for (int bj = 0; bj < 2; ++bj) { const i32x4 i0 = __builtin_bit_cast(i32x4, acc[ai][bj][m][0]), i1 = __builtin_bit_cast(i32x4, acc[ai][bj][m][1]);
                    f32x4 v0 = (f32x4){(float)i0[0], (float)i0[1], (float)i0[2], (float)i0[3]} * cw[bj][0] * rs, v1 = (f32x4){(float)i1[0], (float)i1[1], (float)i1[2], (float)i1[3]} * cw[bj][1] * rs;
                    if (sig) {
#pragma unroll
                        for (int q = 0; q < 4; ++q) { v0[q] = fast_sigmoid(v0[q]); v1[q] = fast_sigmoid(v1[q]); } }
                    u32x4 w; w.x = cvt_pk_bf16(v0[0], v0[1]); w.y = cvt_pk_bf16(v0[2], v0[3]); w.z = cvt_pk_bf16(v1[0], v1[1]); w.w = cvt_pk_bf16(v1[2], v1[3]);
                    *(u32x4*)(rowp + bj * HALF) = w; } }
    }
};
struct EpiF32 {
    static constexpr bool PERM = false, AFTER_DRAIN = false;
    float* O; int ldc; const float* bias; int bias_stride;
    __device__ __forceinline__ void operator()(const f32x4 (&acc)[2][2][4][2], const Unit& u, int wr, int wc, int fr, int fq) const {
        const int row0 = u.pm * BM + wr * 64 + fr, col0 = u.pn * BM + wc * 32 + 4 * fq;
        f32x4 bv[2][2];
#pragma unroll
        for (int bj = 0; bj < 2; ++bj)
#pragma unroll
            for (int n = 0; n < 2; ++n) bv[bj][n] = bias ? *(const f32x4*)(bias + (size_t)u.e * bias_stride + col0 + bj * HALF + n * 16) : (f32x4){0.f, 0.f, 0.f, 0.f};
#pragma unroll
        for (int ai = 0; ai < 2; ++ai)
#pragma unroll
            for (int m = 0; m < 4; ++m) { float* rowp = O + (size_t)(row0 + ai * HALF + m * 16) * ldc + col0;
#pragma unroll
                for (int bj = 0; bj < 2; ++bj)
#pragma unroll
                    for (int n = 0; n < 2; ++n) *(f32x4*)(rowp + bj * HALF + n * 16) = acc[ai][bj][m][n] + bv[bj][n]; }
    }
};
struct EpiBf16Bias {
    static constexpr bool PERM = true, AFTER_DRAIN = false;
    bf16_t* O; int ldc; const float* bias; int bias_stride;
    __device__ __forceinline__ void operator()(const f32x4 (&acc)[2][2][4][2], const Unit& u, int wr, int wc, int fr, int fq) const {
        const int row0 = u.pm * BM + wr * 64 + fr, col0 = u.pn * BM + wc * 32 + 8 * fq;
        f32x4 bv[2][2];
#pragma unroll
        for (int bj = 0; bj < 2; ++bj)
#pragma unroll
            for (int n = 0; n < 2; ++n) bv[bj][n] = bias ? *(const f32x4*)(bias + (size_t)u.e * bias_stride + col0 + bj * HALF + 4 * n) : (f32x4){0.f, 0.f, 0.f, 0.f};
#pragma unroll
        for (int ai = 0; ai < 2; ++ai)
#pragma unroll
            for (int m = 0; m < 4; ++m) { bf16_t* rowp = O + (size_t)(row0 + ai * HALF + m * 16) * ldc + col0;
#pragma unroll
                for (int bj = 0; bj < 2; ++bj) { const f32x4 v0 = acc[ai][bj][m][0] + bv[bj][0], v1 = acc[ai][bj][m][1] + bv[bj][1];
                    u32x4 w; w.x = cvt_pk_bf16(v0[0], v0[1]); w.y = cvt_pk_bf16(v0[2], v0[3]); w.z = cvt_pk_bf16(v1[0], v1[1]); w.w = cvt_pk_bf16(v1[2], v1[3]);
                    *(u32x4*)(rowp + bj * HALF) = w; } }
    }
};
struct EpiBf16I8 {
    static constexpr bool PERM = true, AFTER_DRAIN = false;
    bf16_t* O; int ldc; const float* srow; const float* scol;
    __device__ __forceinline__ void operator()(const f32x4 (&acc)[2][2][4][2], const Unit& u, int wr, int wc, int fr, int fq) const {
        const int row0 = u.pm * BM + wr * 64 + fr, col0 = u.pn * BM + wc * 32 + 8 * fq;
        f32x4 cw[2][2];
#pragma unroll
        for (int bj = 0; bj < 2; ++bj)
#pragma unroll
            for (int n = 0; n < 2; ++n) cw[bj][n] = *(const f32x4*)(scol + col0 + bj * HALF + 4 * n);
#pragma unroll
        for (int ai = 0; ai < 2; ++ai)
#pragma unroll
            for (int m = 0; m < 4; ++m) { const int row = row0 + ai * HALF + m * 16; const float rs = srow[row]; bf16_t* rowp = O + (size_t)row * ldc + col0;
#pragma unroll
                for (int bj = 0; bj < 2; ++bj) { const i32x4 i0 = __builtin_bit_cast(i32x4, acc[ai][bj][m][0]), i1 = __builtin_bit_cast(i32x4, acc[ai][bj][m][1]);
                    const f32x4 v0 = (f32x4){(float)i0[0], (float)i0[1], (float)i0[2], (float)i0[3]} * cw[bj][0] * rs, v1 = (f32x4){(float)i1[0], (float)i1[1], (float)i1[2], (float)i1[3]} * cw[bj][1] * rs;
                    u32x4 w; w.x = cvt_pk_bf16(v0[0], v0[1]); w.y = cvt_pk_bf16(v0[2], v0[3]); w.z = cvt_pk_bf16(v1[0], v1[1]); w.w = cvt_pk_bf16(v1[2], v1[3]);
                    *(u32x4*)(rowp + bj * HALF) = w; } }
    }
};
struct EpiSwiGLUI8 {
    static constexpr bool PERM = true, AFTER_DRAIN = false;
    bf16_t* O; const float* bias; const float* srow; const float* scol;
    __device__ __forceinline__ float act(float g, float up) const {
        g = fminf(g, SW_LIMIT); up = fminf(fmaxf(up, -SW_LIMIT), SW_LIMIT);
        return (up + 1.0f) * (g * __builtin_amdgcn_rcpf(1.0f + __builtin_amdgcn_exp2f(-SW_ALPHA * LOG2E * g)));
    }
    __device__ __forceinline__ void operator()(const f32x4 (&acc)[2][2][4][2], const Unit& u, int wr, int wc, int fr, int fq) const {
        const int row0 = u.pm * BM + wr * 64 + fr, col0 = u.pn * BM + wc * 32 + 8 * fq;
        f32x4 bv[2][2], cw[2][2];
#pragma unroll
        for (int bj = 0; bj < 2; ++bj)
#pragma unroll
            for (int n = 0; n < 2; ++n) { bv[bj][n] = *(const f32x4*)(bias + (size_t)u.e * (2 * DFF) + col0 + bj * HALF + 4 * n); cw[bj][n] = *(const f32x4*)(scol + (size_t)u.e * (2 * DFF) + col0 + bj * HALF + 4 * n); }
#pragma unroll
        for (int ai = 0; ai < 2; ++ai)
#pragma unroll
            for (int m = 0; m < 4; ++m) { const int row = row0 + ai * HALF + m * 16; const float rs = srow[row]; bf16_t* rowp = O + (size_t)row * DFF + (col0 >> 1);
#pragma unroll
                for (int bj = 0; bj < 2; ++bj) { const i32x4 i0 = __builtin_bit_cast(i32x4, acc[ai][bj][m][0]), i1 = __builtin_bit_cast(i32x4, acc[ai][bj][m][1]);
                    const f32x4 v0 = (f32x4){(float)i0[0], (float)i0[1], (float)i0[2], (float)i0[3]} * cw[bj][0] * rs + bv[bj][0], v1 = (f32x4){(float)i1[0], (float)i1[1], (float)i1[2], (float)i1[3]} * cw[bj][1] * rs + bv[bj][1];
                    u32x2 w; w.x = cvt_pk_bf16(act(v0[0], v0[1]), act(v0[2], v0[3])); w.y = cvt_pk_bf16(act(v1[0], v1[1]), act(v1[2], v1[3]));
                    *(u32x2*)(rowp + bj * (HALF / 2)) = w; } }
    }
};
struct EpiSwiGLU {
    static constexpr bool PERM = true, AFTER_DRAIN = false;
    bf16_t* O; const float* bias;
    __device__ __forceinline__ float act(float g, float up) const {
        g = fminf(g, SW_LIMIT); up = fminf(fmaxf(up, -SW_LIMIT), SW_LIMIT);
        return (up + 1.0f) * (g * __builtin_amdgcn_rcpf(1.0f + __builtin_amdgcn_exp2f(-SW_ALPHA * LOG2E * g)));
    }
    __device__ __forceinline__ void operator()(const f32x4 (&acc)[2][2][4][2], const Unit& u, int wr, int wc, int fr, int fq) const {
        const int row0 = u.pm * BM + wr * 64 + fr, col0 = u.pn * BM + wc * 32 + 8 * fq;
        f32x4 bv[2][2];
#pragma unroll
        for (int bj = 0; bj < 2; ++bj)
#pragma unroll
            for (int n = 0; n < 2; ++n) bv[bj][n] = *(const f32x4*)(bias + (size_t)u.e * (2 * DFF) + col0 + bj * HALF + 4 * n);
#pragma unroll
        for (int ai = 0; ai < 2; ++ai)
#pragma unroll
            for (int m = 0; m < 4; ++m) { bf16_t* rowp = O + (size_t)(row0 + ai * HALF + m * 16) * DFF + (col0 >> 1);
#pragma unroll
                for (int bj = 0; bj < 2; ++bj) { const f32x4 v0 = acc[ai][bj][m][0] + bv[bj][0], v1 = acc[ai][bj][m][1] + bv[bj][1];
                    u32x2 w; w.x = cvt_pk_bf16(act(v0[0], v0[1]), act(v0[2], v0[3])); w.y = cvt_pk_bf16(act(v1[0], v1[1]), act(v1[2], v1[3]));
                    *(u32x2*)(rowp + bj * (HALF / 2)) = w; } }
    }
};

template <class Epi, class Sched, bool ALIGN_EPI = false, bool SP2 = false, bool GATHER = false, bool I8 = false>
__device__ __forceinline__ void gemm_phase(PG8_LAS unsigned char* lds, const Gemm g, const Sched& S, const Epi& E) {
    const int tid = otid(), wid = __builtin_amdgcn_readfirstlane(tid >> 6), lane = tid & 63, wr = wid >> 2, wc = wid & 3, fr = lane & 15, fq = lane >> 4;
    const int K = g.K, nt = K / BK;
    unsigned voffA[2], voffB[2];
#pragma unroll
    for (int i = 0; i < 2; ++i) { int R, C; stage_rc(tid * 16 + i * 8192, R, C); const int Rb = Epi::PERM ? ((R & ~31) + perm32(R & 31)) : R;
        voffA[i] = (unsigned)(R * K + C) * 2u; voffB[i] = (unsigned)(Rb * K + C) * 2u; }
    PG8_LAS int* ltok = (PG8_LAS int*)(lds + STAGE_BYTES);
    int gR[2], gC[2];
#pragma unroll
    for (int i = 0; i < 2; ++i) { int R, C; stage_rc(tid * 16 + i * 8192, R, C); gR[i] = R; gC[i] = C * 2; }
    unsigned vcur[2][2], vnxt[2][2];
    const char* gA = (const char*)g.A;
#define PG8_GOFF(dst, ui_) do { _Pragma("unroll") for (int h_ = 0; h_ < 2; ++h_) _Pragma("unroll") for (int i_ = 0; i_ < 2; ++i_) \
        dst[h_][i_] = (unsigned)ltok[(ui_) * 256 + h_ * HALF + gR[i_]] * (unsigned)(K * 2) + (unsigned)gC[i_]; } while (0)
    if constexpr (GATHER) {
        Unit u_; for (int i = 0; S.next(i, u_); ++i) { if (tid < 256) ltok[i * 256 + tid] = g.rowidx[u_.pm * BM + tid]; }
        __syncthreads();
    }
    const size_t kstep = (size_t)(BK * 2);
    const size_t hstep = (size_t)HALF * K * 2;
    const size_t tstep = 2 * hstep;
    const unsigned ldsw = (unsigned)wid * 1024u;
    const int aoff = lds_byte(wr * 64 + fr, fq * 8), boff = lds_byte(wc * 32 + fr, fq * 8);
#define PG8_SA(b, h) (((b) * 2 + (h)) * HTB)
#define PG8_SB(b, h) ((4 + (b) * 2 + (h)) * HTB)
#define PG8_STAGE(bufoff, gbase, voff) do { _Pragma("unroll") for (int _i = 0; _i < 2; ++_i) \
        __builtin_amdgcn_global_load_lds((const unsigned*)((const char*)(gbase) + (voff)[_i]), (PG8_LAS unsigned*)(lds + (bufoff) + ldsw + _i * 8192), 16, 0, 0); } while (0)
#define PG8_LDA(dst, b, h) do { _Pragma("unroll") for (int m = 0; m < 4; ++m) _Pragma("unroll") for (int k = 0; k < 2; ++k) dst[m][k] = *(const PG8_LAS bf16x8*)(lds + PG8_SA(b, h) + aoff + m * 2048 + k * 1024); } while (0)
#define PG8_LDB(dst, b, h) do { _Pragma("unroll") for (int n = 0; n < 2; ++n) _Pragma("unroll") for (int k = 0; k < 2; ++k) dst[n][k] = *(const PG8_LAS bf16x8*)(lds + PG8_SB(b, h) + boff + n * 2048 + k * 1024); } while (0)
#define PG8_MMA(ai, bj, At, Bt) do { __builtin_amdgcn_s_setprio(1); _Pragma("unroll") for (int m = 0; m < 4; ++m) _Pragma("unroll") for (int n = 0; n < 2; ++n) _Pragma("unroll") for (int k = 0; k < 2; ++k) { \
        if constexpr (I8) acc[ai][bj][m][n] = __builtin_bit_cast(f32x4, __builtin_amdgcn_mfma_i32_16x16x64_i8(__builtin_bit_cast(i32x4, Bt[n][k]), __builtin_bit_cast(i32x4, At[m][k]), __builtin_bit_cast(i32x4, acc[ai][bj][m][n]), 0, 0, 0)); \
        else acc[ai][bj][m][n] = __builtin_amdgcn_mfma_f32_16x16x32_bf16(Bt[n][k], At[m][k], acc[ai][bj][m][n], 0, 0, 0); } __builtin_amdgcn_s_setprio(0); } while (0)
#define PG8_WAIT_V(n) asm volatile("s_waitcnt vmcnt(" #n ")" ::: "memory")
#define PG8_WAIT_L(n) asm volatile("s_waitcnt lgkmcnt(" #n ")" ::: "memory")
#define PG8_BAR __builtin_amdgcn_s_barrier()
#define PG8_SCHED __builtin_amdgcn_sched_barrier(0)
    Unit cur, nxt; int ui = 0;
    if (!S.next(0, cur)) return;
    f32x4 acc[2][2][4][2];
#pragma unroll
    for (int a = 0; a < 2; ++a)
#pragma unroll
        for (int b = 0; b < 2; ++b)
#pragma unroll
            for (int m = 0; m < 4; ++m)
#pragma unroll
                for (int n = 0; n < 2; ++n) acc[a][b][m][n] = (f32x4){0.f, 0.f, 0.f, 0.f};
    bf16x8 At[4][2], B0[2][2], B1[2][2];
    const char* cA = (const char*)g.A + (size_t)cur.pm * tstep; const char* cB = (const char*)g.Bt + (size_t)cur.e * g.bstride + (size_t)cur.pn * tstep;
    S.a_ready(cur);
    if constexpr (GATHER) { PG8_GOFF(vcur, 0); }
    if constexpr (SP2) {
        PG8_STAGE(PG8_SB(0, 0), cB, voffB); PG8_STAGE(PG8_SB(0, 1), cB + hstep, voffB);
        if constexpr (GATHER) { PG8_STAGE(PG8_SA(0, 0), gA, vcur[0]); PG8_STAGE(PG8_SA(0, 1), gA, vcur[1]); } else { PG8_STAGE(PG8_SA(0, 0), cA, voffA); PG8_STAGE(PG8_SA(0, 1), cA + hstep, voffA); }
        if (wr == 1) PG8_BAR;
        PG8_WAIT_V(2); PG8_BAR;
        PG8_STAGE(PG8_SB(1, 0), cB + kstep, voffB); if constexpr (GATHER) { PG8_STAGE(PG8_SA(1, 0), gA + kstep, vcur[0]); } else { PG8_STAGE(PG8_SA(1, 0), cA + kstep, voffA); } PG8_STAGE(PG8_SB(1, 1), cB + hstep + kstep, voffB);
        PG8_WAIT_V(6); PG8_BAR;
    } else {
        PG8_STAGE(PG8_SB(0, 0), cB, voffB); PG8_STAGE(PG8_SA(0, 0), cA, voffA); PG8_STAGE(PG8_SB(0, 1), cB + hstep, voffB); PG8_STAGE(PG8_SA(0, 1), cA + hstep, voffA);
        if (wr == 1) PG8_BAR;
        PG8_WAIT_V(4); PG8_BAR;
        PG8_STAGE(PG8_SB(1, 0), cB + kstep, voffB); PG8_STAGE(PG8_SA(1, 0), cA + kstep, voffA); PG8_STAGE(PG8_SB(1, 1), cB + hstep + kstep, voffB);
        PG8_WAIT_V(6); PG8_BAR;
    }
    for (;;) {
        const bool has_next = S.next(ui + 1, nxt);
        if constexpr (GATHER) { if (has_next) { PG8_GOFF(vnxt, ui + 1); } else { _Pragma("unroll") for (int h_ = 0; h_ < 2; ++h_) _Pragma("unroll") for (int i_ = 0; i_ < 2; ++i_) vnxt[h_][i_] = vcur[h_][i_]; } }
        const char* nA = has_next ? (const char*)g.A + (size_t)nxt.pm * tstep : cA; const char* nB = has_next ? (const char*)g.Bt + (size_t)nxt.e * g.bstride + (size_t)nxt.pn * tstep : cB;
#pragma unroll 1
        for (int t = 0; t < nt; t += 2) {
            const bool last = (t == nt - 2);
            const char* a1 = cA + (size_t)(t + 1) * kstep;
            const char* a2 = last ? nA : cA + (size_t)(t + 2) * kstep; const char* b2 = last ? nB : cB + (size_t)(t + 2) * kstep;
            const char* a3 = a2 + kstep; const char* b3 = b2 + kstep;
            const size_t ko1 = (size_t)(t + 1) * kstep, ko2 = last ? (size_t)0 : (size_t)(t + 2) * kstep, ko3 = ko2 + kstep; unsigned v2[2][2];
            if constexpr (GATHER) { _Pragma("unroll") for (int h_ = 0; h_ < 2; ++h_) _Pragma("unroll") for (int i_ = 0; i_ < 2; ++i_) v2[h_][i_] = last ? vnxt[h_][i_] : vcur[h_][i_]; }
            if (last && has_next) S.a_ready(nxt);
            if constexpr (SP2) {
            PG8_LDB(B0, 0, 0); PG8_LDB(B1, 0, 1); PG8_SCHED; PG8_LDA(At, 0, 0); if constexpr (GATHER) { PG8_STAGE(PG8_SA(1, 1), gA + ko1, vcur[1]); } else { PG8_STAGE(PG8_SA(1, 1), a1 + hstep, voffA); }
            PG8_WAIT_V(8); PG8_WAIT_L(0); PG8_BAR; PG8_MMA(0, 0, At, B0); PG8_MMA(0, 1, At, B1); PG8_BAR; PG8_SCHED;
            PG8_LDA(At, 0, 1); PG8_STAGE(PG8_SB(0, 0), b2, voffB); PG8_STAGE(PG8_SB(0, 1), b2 + hstep, voffB); if constexpr (GATHER) { PG8_STAGE(PG8_SA(0, 0), gA + ko2, v2[0]); } else { PG8_STAGE(PG8_SA(0, 0), a2, voffA); }
            PG8_WAIT_V(8); PG8_WAIT_L(0); PG8_BAR; PG8_MMA(1, 0, At, B0); PG8_MMA(1, 1, At, B1); PG8_BAR; PG8_SCHED;
            PG8_LDB(B0, 1, 0); PG8_LDB(B1, 1, 1); PG8_SCHED; PG8_LDA(At, 1, 0); if constexpr (GATHER) { PG8_STAGE(PG8_SA(0, 1), gA + ko2, v2[1]); } else { PG8_STAGE(PG8_SA(0, 1), a2 + hstep, voffA); }
            PG8_WAIT_V(8); PG8_WAIT_L(0); PG8_BAR; PG8_MMA(0, 0, At, B0); PG8_MMA(0, 1, At, B1); PG8_BAR; PG8_SCHED;
            PG8_LDA(At, 1, 1); PG8_STAGE(PG8_SB(1, 0), b3, voffB); PG8_STAGE(PG8_SB(1, 1), b3 + hstep, voffB); if constexpr (GATHER) { PG8_STAGE(PG8_SA(1, 0), gA + ko3, v2[0]); } else { PG8_STAGE(PG8_SA(1, 0), a3, voffA); }
            PG8_WAIT_V(8); PG8_WAIT_L(0); PG8_BAR; PG8_MMA(1, 0, At, B0); PG8_MMA(1, 1, At, B1); PG8_BAR; PG8_SCHED;
            } else {
            PG8_LDB(B0, 0, 0); PG8_SCHED; PG8_LDA(At, 0, 0); PG8_STAGE(PG8_SA(1, 1), a1 + hstep, voffA);
            PG8_WAIT_L(8); PG8_BAR; PG8_WAIT_L(0); PG8_MMA(0, 0, At, B0); PG8_BAR; PG8_SCHED;
            PG8_LDB(B1, 0, 1); PG8_STAGE(PG8_SB(0, 0), b2, voffB);
            PG8_BAR; PG8_WAIT_L(0); PG8_MMA(0, 1, At, B1); PG8_BAR;
            PG8_LDA(At, 0, 1); PG8_STAGE(PG8_SA(0, 0), a2, voffA);
            PG8_BAR; PG8_WAIT_L(0); PG8_MMA(1, 0, At, B0); PG8_BAR; PG8_SCHED;
            PG8_STAGE(PG8_SB(0, 1), b2 + hstep, voffB);
            PG8_WAIT_V(6); PG8_BAR; PG8_MMA(1, 1, At, B1); PG8_BAR;
            PG8_LDB(B0, 1, 0); PG8_SCHED; PG8_LDA(At, 1, 0); PG8_STAGE(PG8_SA(0, 1), a2 + hstep, voffA);
            PG8_WAIT_L(8); PG8_BAR; PG8_WAIT_L(0); PG8_MMA(0, 0, At, B0); PG8_BAR; PG8_SCHED;
            PG8_LDB(B1, 1, 1); PG8_STAGE(PG8_SB(1, 0), b3, voffB);
            PG8_BAR; PG8_WAIT_L(0); PG8_MMA(0, 1, At, B1); PG8_BAR;
            PG8_LDA(At, 1, 1); PG8_STAGE(PG8_SA(1, 0), a3, voffA);
            PG8_BAR; PG8_WAIT_L(0); PG8_MMA(1, 0, At, B0); PG8_BAR; PG8_SCHED;
            PG8_STAGE(PG8_SB(1, 1), b3 + hstep, voffB);
            PG8_WAIT_V(6); PG8_BAR; PG8_MMA(1, 1, At, B1); PG8_BAR;
            }
        }
        if constexpr (ALIGN_EPI) { if (wr == 0) PG8_BAR; }
        if constexpr (!Epi::AFTER_DRAIN) { E(acc, cur, wr, wc, fr, fq); S.done(cur); }
        if (!has_next) break;
#pragma unroll
        for (int a = 0; a < 2; ++a)
#pragma unroll
            for (int b = 0; b < 2; ++b)
#pragma unroll
                for (int m = 0; m < 4; ++m)
#pragma unroll
                    for (int n = 0; n < 2; ++n) acc[a][b][m][n] = (f32x4){0.f, 0.f, 0.f, 0.f};
        cur = nxt; cA = nA; cB = nB; ++ui;
        if constexpr (GATHER) { _Pragma("unroll") for (int h_ = 0; h_ < 2; ++h_) _Pragma("unroll") for (int i_ = 0; i_ < 2; ++i_) vcur[h_][i_] = vnxt[h_][i_]; }
        if constexpr (ALIGN_EPI) { if (wr == 1) PG8_BAR; }
    }
    PG8_WAIT_V(0);
    if constexpr (!ALIGN_EPI) { if (wr == 0) PG8_BAR; }
    PG8_BAR;
    if constexpr (Epi::AFTER_DRAIN) { E.fused(acc, cur, wr, wc, fr, fq, lds, wid, lane); S.done(cur); }
#undef PG8_SA
#undef PG8_GOFF
#undef PG8_SB
#undef PG8_STAGE
#undef PG8_LDA
#undef PG8_LDB
#undef PG8_MMA
#undef PG8_WAIT_V
#undef PG8_WAIT_L
#undef PG8_BAR
#undef PG8_SCHED
}

}

namespace att {
typedef unsigned short bf16_t;
using bf16x8 = __attribute__((ext_vector_type(8))) short;
using s16x4  = __attribute__((ext_vector_type(4))) short;
using f32x16 = __attribute__((ext_vector_type(16))) float;
using f32x4  = __attribute__((ext_vector_type(4))) float;
using u32x4  = __attribute__((ext_vector_type(4))) unsigned;
#define ATT_LAS __attribute__((address_space(3)))
#define SBAR() __builtin_amdgcn_sched_barrier(0)
constexpr int PITCH = DIN;
constexpr float THR = 8.0f;
constexpr float NEG_BIG = -1e30f;
constexpr int FL_K = 0, FL_KB = 8192, FL_V = 24576, FL_VB = 16384, FL_WS = 98304, FL_Q = 100352;
constexpr int SW_K = 0, SW_V = 49152, SW_VT = 8192;
constexpr int NQR = 4;
constexpr int FL_FLG = FL_Q + 8 * (8 - NQR) * 1024;
constexpr int ATT_LDS = FL_FLG + 64;

__device__ __forceinline__ int crow(int r, int hi) { return (r & 3) + 8 * (r >> 2) + 4 * hi; }
__device__ __forceinline__ unsigned cvtpk(float lo, float hi) { unsigned r; asm volatile("v_cvt_pk_bf16_f32 %0, %1, %2" : "=v"(r) : "v"(lo), "v"(hi)); return r; }
__device__ __forceinline__ int kswz256(int row, int colB) { return row * 256 + (colB ^ ((row & 7) << 4)); }
__device__ __forceinline__ int kswz128(int row, int colB) { return row * 128 + (colB ^ ((row & 7) << 4)); }
template <int NCB> __device__ __forceinline__ int v_st(int k, int c) { const int kk = (k & ~0xC) | ((k & 4) << 1) | ((k & 8) >> 1); return ((kk >> 3) * NCB + (c >> 5)) * 512 + ((kk & 7) * 32 + (c & 31)) * 2; }
__device__ __forceinline__ int v_rd_base(int lane) { return ((lane & 3) << 3) | (((lane >> 2) & 3) << 6) | (((lane >> 4) & 1) << 5) | (((lane >> 5) & 1) << 8); }
template <int NCB> constexpr int v_rd_off(int d0, int ks, int half) { return d0 * 512 + (2 * ks + half) * NCB * 512; }
template <int OFF> __device__ __forceinline__ s16x4 tr_read(int vb) { s16x4 r; asm volatile("ds_read_b64_tr_b16 %0, %1 offset:%2" : "=&v"(r) : "v"(vb), "i"(OFF) : "memory"); return r; }
template <int NCB, int D0> __device__ __forceinline__ void pv_one(f32x16& od, int vb, bf16x8 pa0, bf16x8 pa1, bf16x8 pa2, bf16x8 pa3) {
    const s16x4 l0 = tr_read<v_rd_off<NCB>(D0, 0, 0)>(vb), h0 = tr_read<v_rd_off<NCB>(D0, 0, 1)>(vb), l1 = tr_read<v_rd_off<NCB>(D0, 1, 0)>(vb), h1 = tr_read<v_rd_off<NCB>(D0, 1, 1)>(vb);
    const s16x4 l2 = tr_read<v_rd_off<NCB>(D0, 2, 0)>(vb), h2 = tr_read<v_rd_off<NCB>(D0, 2, 1)>(vb), l3 = tr_read<v_rd_off<NCB>(D0, 3, 0)>(vb), h3 = tr_read<v_rd_off<NCB>(D0, 3, 1)>(vb);
    asm volatile("s_waitcnt lgkmcnt(0)" ::: "memory"); SBAR();
#define PK(L, H) (bf16x8){L[0], L[1], L[2], L[3], H[0], H[1], H[2], H[3]}
    od = __builtin_amdgcn_mfma_f32_32x32x16_bf16(pa0, PK(l0, h0), od, 0, 0, 0);
    od = __builtin_amdgcn_mfma_f32_32x32x16_bf16(pa1, PK(l1, h1), od, 0, 0, 0);
    od = __builtin_amdgcn_mfma_f32_32x32x16_bf16(pa2, PK(l2, h2), od, 0, 0, 0);
    od = __builtin_amdgcn_mfma_f32_32x32x16_bf16(pa3, PK(l3, h3), od, 0, 0, 0);
#undef PK
}
__device__ __forceinline__ float half_max(float v) { auto rr = __builtin_amdgcn_permlane32_swap(__float_as_uint(v), __float_as_uint(v), false, false); return fmaxf(__uint_as_float(rr[0]), __uint_as_float(rr[1])); }
__device__ __forceinline__ float half_sum(float v) { auto rr = __builtin_amdgcn_permlane32_swap(__float_as_uint(v), __float_as_uint(v), false, false); return __uint_as_float(rr[0]) + __uint_as_float(rr[1]); }
__device__ __forceinline__ float softmax_step(f32x16& p0, f32x16& p1, float& m_reg, float& l_reg) {
    float pmax = p0[0];
#pragma unroll
    for (int r = 1; r < 16; ++r) pmax = fmaxf(pmax, p0[r]);
#pragma unroll
    for (int r = 0; r < 16; ++r) pmax = fmaxf(pmax, p1[r]);
    pmax = half_max(pmax);
    float alpha = 1.f;
    if (!__all(pmax - m_reg <= THR)) { const float mn = fmaxf(m_reg, pmax); alpha = __builtin_amdgcn_exp2f(m_reg - mn); m_reg = mn; }
    float ps = 0.f;
#pragma unroll
    for (int r = 0; r < 16; ++r) { p0[r] = __builtin_amdgcn_exp2f(p0[r] - m_reg); ps += p0[r]; }
#pragma unroll
    for (int r = 0; r < 16; ++r) { p1[r] = __builtin_amdgcn_exp2f(p1[r] - m_reg); ps += p1[r]; }
    ps = half_sum(ps);
    l_reg = l_reg * alpha + ps;
    return alpha;
}
__device__ __forceinline__ void pack_p(const f32x16& p0, const f32x16& p1, bf16x8& pa0, bf16x8& pa1, bf16x8& pa2, bf16x8& pa3) {
#define PK4(P, BASE, OUT) do { unsigned a0 = cvtpk(P[BASE + 0], P[BASE + 1]), a1 = cvtpk(P[BASE + 2], P[BASE + 3]);   \
    unsigned b0 = cvtpk(P[BASE + 4], P[BASE + 5]), b1 = cvtpk(P[BASE + 6], P[BASE + 7]);                              \
    auto r0 = __builtin_amdgcn_permlane32_swap(a0, b0, false, false); auto r1 = __builtin_amdgcn_permlane32_swap(a1, b1, false, false); \
    u32x4 w = {r0[0], r1[0], r0[1], r1[1]}; OUT = __builtin_bit_cast(bf16x8, w); } while (0)
    PK4(p0, 0, pa0); PK4(p0, 8, pa1); PK4(p1, 0, pa2); PK4(p1, 8, pa3);
#undef PK4
}

struct AttnArgs {
    const bf16_t* proj;
    bf16_t* merged;
    bf16_t* oc;
    const float* subln_g;
    const float* sinks;
    float lam, one_m_lam_init;
    const unsigned* kmax2;
};

#define FPK(L, H) (bf16x8){L[0], L[1], L[2], L[3], H[0], H[1], H[2], H[3]}
#define RDV32(L0, H0, L1, H1, VB, D0) do { L0 = tr_read<v_rd_off<4>(D0, 0, 0)>(VB); H0 = tr_read<v_rd_off<4>(D0, 0, 1)>(VB); L1 = tr_read<v_rd_off<4>(D0, 1, 0)>(VB); H1 = tr_read<v_rd_off<4>(D0, 1, 1)>(VB); } while (0)
#define MMV32(OD, L0, H0, L1, H1) do { OD = __builtin_amdgcn_mfma_f32_32x32x16_bf16(pa0, FPK(L0, H0), OD, 0, 0, 0); OD = __builtin_amdgcn_mfma_f32_32x32x16_bf16(pa1, FPK(L1, H1), OD, 0, 0, 0); } while (0)
#define WAITL32(N) do { asm volatile("s_waitcnt lgkmcnt(" #N ")" ::: "memory"); SBAR(); } while (0)
#define PV32_PIPE(o, vb, V0, V1, V2, V3, V4, V5, V6, V7) do { const int vb1_ = (vb) + 8192; s16x4 al0, ah0, al1, ah1, bl0, bh0, bl1, bh1; \
        RDV32(al0, ah0, al1, ah1, vb, 0); \
        RDV32(bl0, bh0, bl1, bh1, vb, 1);   WAITL32(4); MMV32(o[0], al0, ah0, al1, ah1); V0; SBAR(); \
        RDV32(al0, ah0, al1, ah1, vb, 2);   WAITL32(4); MMV32(o[1], bl0, bh0, bl1, bh1); V1; SBAR(); \
        RDV32(bl0, bh0, bl1, bh1, vb, 3);   WAITL32(4); MMV32(o[2], al0, ah0, al1, ah1); V2; SBAR(); \
        RDV32(al0, ah0, al1, ah1, vb1_, 0); WAITL32(4); MMV32(o[3], bl0, bh0, bl1, bh1); V3; SBAR(); \
        RDV32(bl0, bh0, bl1, bh1, vb1_, 1); WAITL32(4); MMV32(o[4], al0, ah0, al1, ah1); V4; SBAR(); \
        RDV32(al0, ah0, al1, ah1, vb1_, 2); WAITL32(4); MMV32(o[5], bl0, bh0, bl1, bh1); V5; SBAR(); \
        RDV32(bl0, bh0, bl1, bh1, vb1_, 3); WAITL32(4); MMV32(o[6], al0, ah0, al1, ah1); V6; SBAR(); \
        WAITL32(0); MMV32(o[7], bl0, bh0, bl1, bh1); V7; SBAR(); } while (0)
__device__ __forceinline__ void pack32(const f32x16& p, bf16x8& pa0, bf16x8& pa1) {
#define PK4(P, BASE, OUT) do { unsigned a0 = cvtpk(P[BASE + 0], P[BASE + 1]), a1 = cvtpk(P[BASE + 2], P[BASE + 3]);   \
    unsigned b0 = cvtpk(P[BASE + 4], P[BASE + 5]), b1 = cvtpk(P[BASE + 6], P[BASE + 7]);                              \
    auto r0 = __builtin_amdgcn_permlane32_swap(a0, b0, false, false); auto r1 = __builtin_amdgcn_permlane32_swap(a1, b1, false, false); \
    u32x4 w = {r0[0], r1[0], r0[1], r1[1]}; OUT = __builtin_bit_cast(bf16x8, w); } while (0)
    PK4(p, 0, pa0); PK4(p, 8, pa1);
#undef PK4
}
__device__ __forceinline__ void qk32(f32x16& p, const bf16x8 (&qr)[NQR], ATT_LAS const char* qlds, ATT_LAS const char* Ks, int r32, int hi) {
    p = f32x16{};
    int kl = kswz256(r32, hi * 16); asm volatile("" : "+v"(kl));
#pragma unroll
    for (int d0 = 0; d0 < 8; ++d0) {
        const bf16x8 b0 = *(ATT_LAS const bf16x8*)(Ks + (kl ^ (d0 * 32)));
        const bf16x8 qf = d0 < NQR ? qr[d0 < NQR ? d0 : 0] : *(ATT_LAS const bf16x8*)(qlds + (d0 - NQR) * 1024);
        p = __builtin_amdgcn_mfma_f32_32x32x16_bf16(b0, qf, p, 0, 0, 0); }
}
__device__ __forceinline__ float softmax32(f32x16& p, float& m_reg, float& l_reg, float& m_true) {
    float pmax = fmaxf(fmaxf(p[0], p[1]), p[2]);
#pragma unroll
    for (int r = 3; r < 15; r += 2) pmax = fmaxf(fmaxf(pmax, p[r]), p[r + 1]);
    pmax = half_max(fmaxf(pmax, p[15]));
    m_true = fmaxf(m_true, pmax);
    const float mn = (pmax - m_reg <= THR) ? m_reg : pmax;
    const float alpha = __builtin_amdgcn_exp2f(m_reg - mn);
    m_reg = mn;
    float ps = 0.f;
#pragma unroll
    for (int r = 0; r < 16; ++r) { p[r] = __builtin_amdgcn_exp2f(p[r] - mn); ps += p[r]; }
    l_reg = l_reg * alpha + half_sum(ps);
    return alpha;
}
__device__ __forceinline__ void rescale_o(f32x16 (&o)[8], float alpha, ATT_LAS float* wsf, int r32, int hi) {
    if (__any(alpha < 1.f)) {
        if (hi == 0) wsf[r32] = alpha;
#pragma unroll
        for (int g = 0; g < 4; ++g) {
            const f32x4 a4 = *(ATT_LAS const f32x4*)(wsf + 8 * g + 4 * hi);
#pragma unroll
            for (int j = 0; j < 4; ++j)
#pragma unroll
                for (int d = 0; d < 8; ++d) o[d][4 * g + j] *= a4[j];
        }
    }
}
__device__ __forceinline__ void flash_map(f32x16 (&o)[8], const bf16_t* Qw, const bf16_t* Kb, const bf16_t* Vb, int q0, float slope2, float kmax, ATT_LAS char* lds) {
    const int tid = pg8::otid(), lane = tid & 63, r32 = lane & 31, hi = lane >> 5; const int wid = __builtin_amdgcn_readfirstlane(tid >> 6);
    ATT_LAS float* wsf = (ATT_LAS float*)(lds + FL_WS) + wid * 64;
#pragma unroll
    for (int i = 0; i < 8; ++i) o[i] = f32x16{};
    bf16x8 qr[NQR]; float qss = 0.f;
#pragma unroll
    for (int d0 = 0; d0 < NQR; ++d0) { qr[d0] = *reinterpret_cast<const bf16x8*>(Qw + d0 * 16);
#pragma unroll
        for (int j = 0; j < 8; ++j) { const float x = __uint_as_float((unsigned)(unsigned short)qr[d0][j] << 16); qss += x * x; } }
    ATT_LAS char* qlds = lds + FL_Q + wid * ((8 - NQR) * 1024) + lane * 16;
    float m_reg = NEG_BIG, l_reg = 0.f, m_true = NEG_BIG;
    const int NT = (q0 + 256) / 32;
    const int td = q0 / 32 + wid;
    const int qrel = wid * 32 + r32;
    const unsigned koff = (unsigned)((4 * wid + (lane >> 4)) * PITCH + (((lane & 15) ^ ((4 * wid + (lane >> 4)) & 7)) << 3));
    unsigned voff; { const int kk_ = 8 * (wid >> 1) + ((lane & 31) >> 2), k_ = (kk_ & ~0xC) | ((kk_ & 4) << 1) | ((kk_ & 8) >> 1); voff = (unsigned)(k_ * PITCH + 32 * (2 * (wid & 1) + (lane >> 5)) + 8 * (lane & 3)); }
#define FL_DMA_K(t, kb) do { const bf16_t* kt = Kb + (size_t)(t) * 32 * PITCH + koff; \
        __builtin_amdgcn_global_load_lds((const unsigned*)kt, (ATT_LAS unsigned*)(lds + FL_K + (kb) * FL_KB + wid * 1024), 16, 0, 0); } while (0)
#define FL_DMA_V(t, vbf) do { const bf16_t* vt = Vb + (size_t)(t) * 32 * PITCH + voff; \
        __builtin_amdgcn_global_load_lds((const unsigned*)vt, (ATT_LAS unsigned*)(lds + FL_V + (vbf) * FL_VB + wid * 1024), 16, 0, 0); \
        __builtin_amdgcn_global_load_lds((const unsigned*)(vt + 128), (ATT_LAS unsigned*)(lds + FL_V + (vbf) * FL_VB + 8192 + wid * 1024), 16, 0, 0); } while (0)
    const int vrb = (int)(uintptr_t)(lds + FL_V) + v_rd_base(lane);
    __syncthreads();
#pragma unroll
    for (int d0 = 0; d0 < 8 - NQR; ++d0) { const bf16x8 qf = *reinterpret_cast<const bf16x8*>(Qw + (NQR + d0) * 16); *(ATT_LAS bf16x8*)(qlds + d0 * 1024) = qf;
#pragma unroll
        for (int j = 0; j < 8; ++j) { const float x = __uint_as_float((unsigned)(unsigned short)qf[j] << 16); qss += x * x; } }
    const float bq = sqrtf(half_sum(qss)) * kmax;
    const float tstop = 24.0f - __builtin_amdgcn_logf(1.0f - __builtin_amdgcn_exp2f(-slope2));
#if defined(PROBE_NOPRUNE)
    const float tstop_ = 1e30f;
#define tstop tstop_
#endif
    ATT_LAS int* flg = (ATT_LAS int*)(lds + FL_FLG);
    int sl = (NT - 1) % 3;
    int s1 = (sl + 1) % 3, s2 = (sl + 2) % 3;
    FL_DMA_K(NT - 1, sl); FL_DMA_K(NT - 2, s2); FL_DMA_V(NT - 1, sl);
    asm volatile("s_waitcnt vmcnt(0)" ::: "memory"); __syncthreads();
    bf16x8 pa0, pa1;
#define STEP_TAIL(NFLY) \
        {     \
            const bool ok = (bq - m_true - slope2 * (float)(q0 + qrel - 32 * t + 1) + tstop) <= 0.f; \
            const int mydone = __all(ok) ? 1 : 0; \
            if (lane == 0) flg[(it & 1) * 8 + wid] = mydone; \
        } \
          \
        if (t >= 2) asm volatile("s_waitcnt vmcnt(" #NFLY ") lgkmcnt(0)" ::: "memory"); else asm volatile("s_waitcnt vmcnt(0) lgkmcnt(0)" ::: "memory"); \
        __builtin_amdgcn_s_barrier(); asm volatile("" ::: "memory"); \
        {   typedef int i32x4 __attribute__((ext_vector_type(4))); \
            const i32x4 f0 = *(ATT_LAS const i32x4*)(flg + (it & 1) * 8), f1 = *(ATT_LAS const i32x4*)(flg + (it & 1) * 8 + 4); \
            if ((f0.x & f0.y & f0.z & f0.w & f1.x & f1.y & f1.z & f1.w) != 0) { stopped = true; break; } } \
        { const int o_ = s1; s1 = sl; sl = s2; s2 = o_; }
    bool stopped = false;
    int it = 0;
    if (wid >= 4) __builtin_amdgcn_s_setprio(2);
    for (; it < 8; ++it) {
        const int t = NT - 1 - it;
        if (t >= 1) FL_DMA_V(t - 1, s2);
        if (t >= 2) FL_DMA_K(t - 2, s1);
        if (t <= td) {
            f32x16 p; qk32(p, qr, qlds, lds + FL_K + sl * FL_KB, r32, hi);
            float s2v = slope2; asm volatile("" : "+v"(s2v));
            const float biasbase = s2v * (float)(t * 32 - q0 + 4 * hi - qrel);
            if (t == td) {
#pragma unroll
                for (int r = 0; r < 16; ++r) { const int kr = (r & 3) + 8 * (r >> 2) + 4 * hi; p[r] = (kr > r32) ? -INFINITY : fmaf(s2v, (float)((r & 3) + 8 * (r >> 2)), p[r] + biasbase); }
            } else {
#pragma unroll
                for (int r = 0; r < 16; ++r) p[r] = fmaf(s2v, (float)((r & 3) + 8 * (r >> 2)), p[r] + biasbase);
            }
            const float alpha = softmax32(p, m_reg, l_reg, m_true);
            rescale_o(o, alpha, wsf, r32, hi);
            pack32(p, pa0, pa1);
            const int vbt = vrb + sl * FL_VB;
            PV32_PIPE(o, vbt, (void)0, (void)0, (void)0, (void)0, (void)0, (void)0, (void)0, (void)0);
        }
        STEP_TAIL(1)
    }
    pa0 = bf16x8{}; pa1 = bf16x8{};
    if (!stopped) for (; it < NT; ++it) {
        const int t = NT - 1 - it;
        f32x16 p; qk32(p, qr, qlds, lds + FL_K + sl * FL_KB, r32, hi);
#if defined(PROBE_QK2)
        asm volatile("" : "+v"(p)); qk32(p, qr, qlds, lds + FL_K + sl * FL_KB, r32, hi);
#endif
        if (t >= 1) FL_DMA_V(t - 1, s2);
        if (t >= 2) FL_DMA_K(t - 2, s1);
        float s2v = slope2; asm volatile("" : "+v"(s2v));
        const float biasbase = s2v * (float)(t * 32 - q0 + 4 * hi - qrel);
        const int vbp = vrb + s1 * FL_VB;
        float alpha, pmax, mn, mnb, ps;
#define BIAS(r) p[r] = fmaf(s2v, (float)(((r) & 3) + 8 * ((r) >> 2)), p[r])
#define EXPS(r) do { p[r] = __builtin_amdgcn_exp2f(p[r] - mnb); ps += p[r]; } while (0)
#define VCH1 do { BIAS(0); BIAS(1); BIAS(2); BIAS(3); BIAS(4); BIAS(5); BIAS(6); BIAS(7); } while (0)
#define VCH2 do { BIAS(8); BIAS(9); BIAS(10); BIAS(11); BIAS(12); BIAS(13); BIAS(14); BIAS(15); } while (0)
#define VCH3 do { float a_ = fmaxf(fmaxf(p[0], p[1]), p[2]); float b_ = fmaxf(fmaxf(p[3], p[4]), p[5]); a_ = fmaxf(fmaxf(a_, p[6]), p[7]); b_ = fmaxf(fmaxf(b_, p[8]), p[9]); \
                  a_ = fmaxf(fmaxf(a_, p[10]), p[11]); b_ = fmaxf(fmaxf(b_, p[12]), p[13]); a_ = fmaxf(fmaxf(a_, p[14]), p[15]); pmax = half_max(fmaxf(a_, b_) + biasbase); \
                  m_true = fmaxf(m_true, pmax); mn = (pmax - m_reg <= THR) ? m_reg : pmax; alpha = __builtin_amdgcn_exp2f(m_reg - mn); m_reg = mn; mnb = mn - biasbase; ps = 0.f; } while (0)
#define VCH4 do { EXPS(0); EXPS(1); EXPS(2); EXPS(3); } while (0)
#define VCH5 do { EXPS(4); EXPS(5); EXPS(6); EXPS(7); } while (0)
#define VCH6 do { EXPS(8); EXPS(9); EXPS(10); EXPS(11); } while (0)
#define VCH7 do { EXPS(12); EXPS(13); EXPS(14); EXPS(15); } while (0)
#if defined(PROBE_PV3)
        { PV32_PIPE(o, vbp, (void)0, (void)0, (void)0, (void)0, (void)0, (void)0, (void)0, (void)0);
          const bf16x8 sgn = {(short)0x8000, (short)0x8000, (short)0x8000, (short)0x8000, (short)0x8000, (short)0x8000, (short)0x8000, (short)0x8000};
          pa0 ^= sgn; pa1 ^= sgn; PV32_PIPE(o, vbp, (void)0, (void)0, (void)0, (void)0, (void)0, (void)0, (void)0, (void)0); pa0 ^= sgn; pa1 ^= sgn; }
#endif
        PV32_PIPE(o, vbp, (void)0, VCH1, VCH2, VCH3, VCH4, VCH5, VCH6, VCH7);
#undef VCH1
#undef VCH2
#undef VCH3
#undef VCH4
#undef VCH5
#undef VCH6
#undef VCH7
#undef BIAS
#undef EXPS
        l_reg = l_reg * alpha + half_sum(ps);
        rescale_o(o, alpha, wsf, r32, hi);
        pack32(p, pa0, pa1);
        STEP_TAIL(3)
    }
#undef STEP_TAIL
    __builtin_amdgcn_s_setprio(0);
    asm volatile("s_waitcnt vmcnt(0)" ::: "memory");
    { const int sll = (it < NT) ? sl : s1; const int vbl = vrb + sll * FL_VB;
      PV32_PIPE(o, vbl, (void)0, (void)0, (void)0, (void)0, (void)0, (void)0, (void)0, (void)0); }
#undef FL_DMA_K
#undef FL_DMA_V
    if (hi == 0) wsf[32 + r32] = l_reg;
    asm volatile("s_waitcnt lgkmcnt(0)" ::: "memory");
#pragma unroll
    for (int r = 0; r < 16; ++r) { const float rl = 1.0f / wsf[32 + crow(r, hi)];
#pragma unroll
        for (int d = 0; d < 8; ++d) o[d][r] *= rl; }
}
#undef FPK
#undef RDV32
#undef MMV32
#undef WAITL32
#undef PV32_PIPE

__device__ __forceinline__ void swa_part(const AttnArgs& A, int b, int h, int q0, ATT_LAS char* lds) {
    const int tid = pg8::otid(), lane = tid & 63, r32 = lane & 31, hi = lane >> 5; const int wid = __builtin_amdgcn_readfirstlane(tid >> 6);
    const int kvh = h >> 1;
    const size_t tok0 = (size_t)b * SEQ + q0;
    __syncthreads();
    for (int i = tid; i < 384 * 8; i += 512) {
        const int row = i >> 3, ch = i & 7; const int kpos = q0 - 128 + row;
        bf16x8 kv = bf16x8{}, vv = bf16x8{};
        if (kpos >= 0) { const bf16_t* p = A.proj + ((size_t)b * SEQ + kpos) * PITCH; kv = *reinterpret_cast<const bf16x8*>(p + C_KB + kvh * 64 + ch * 8); vv = *reinterpret_cast<const bf16x8*>(p + C_VB + kvh * 64 + ch * 8); }
        *(ATT_LAS bf16x8*)(lds + SW_K + kswz128(row, ch * 16)) = kv;
        *(ATT_LAS bf16x8*)(lds + SW_V + (row >> 6) * SW_VT + v_st<2>(row & 63, ch * 8)) = vv;
    }
    __syncthreads();
    ATT_LAS float* wsf = (ATT_LAS float*)(lds + FL_WS) + wid * 64;
    const int qrel = wid * 32 + r32;
    const int vrb = (int)(uintptr_t)(lds + SW_V) + v_rd_base(lane);
    for (int hh = 0; hh < 4; ++hh) {
        const int hq = 4 * h + hh;
        const float slope2 = __builtin_amdgcn_exp2f(-0.5f * (float)(hq + 1)) * LOG2E;
        const bf16_t* Qw = A.proj + (tok0 + qrel) * PITCH + C_QB + hq * 64 + hi * 8;
        bf16x8 qr[4];
#pragma unroll
        for (int d0 = 0; d0 < 4; ++d0) qr[d0] = *reinterpret_cast<const bf16x8*>(Qw + d0 * 16);
        float m_reg = A.sinks[hq] * LOG2E, l_reg = 1.0f;
        f32x16 o[2]; o[0] = f32x16{}; o[1] = f32x16{};
        for (int i = 0; i < 3; ++i) {
            const int jt = (wid >> 1) + i;
            f32x16 p0 = f32x16{}, p1 = f32x16{};
            { ATT_LAS const char* Ks = lds + SW_K + jt * 64 * 128;
#pragma unroll
              for (int d0 = 0; d0 < 4; ++d0) { const int cb = (d0 * 16 + hi * 8) * 2;
                  const bf16x8 b0 = *(ATT_LAS const bf16x8*)(Ks + kswz128(r32, cb));
                  const bf16x8 b1 = *(ATT_LAS const bf16x8*)(Ks + kswz128(32 + r32, cb));
                  p0 = __builtin_amdgcn_mfma_f32_32x32x16_bf16(b0, qr[d0], p0, 0, 0, 0);
                  p1 = __builtin_amdgcn_mfma_f32_32x32x16_bf16(b1, qr[d0], p1, 0, 0, 0); } }
            const int krel0 = -128 + 64 * jt + 4 * hi;
#pragma unroll
            for (int r = 0; r < 16; ++r) {
                const int kr = krel0 + (r & 3) + 8 * (r >> 2);
                { const int dist = qrel - kr; const bool ok = (dist >= 0) && (dist < 128) && (q0 + kr >= 0); p0[r] = ok ? p0[r] - slope2 * (float)dist : -INFINITY; }
                { const int dist = qrel - kr - 32; const bool ok = (dist >= 0) && (dist < 128) && (q0 + kr + 32 >= 0); p1[r] = ok ? p1[r] - slope2 * (float)dist : -INFINITY; }
            }
            const float alpha = softmax_step(p0, p1, m_reg, l_reg);
            if (__any(alpha < 1.f)) {
                if (hi == 0) wsf[r32] = alpha;
                asm volatile("s_waitcnt lgkmcnt(0)" ::: "memory");
#pragma unroll
                for (int r = 0; r < 16; ++r) { const float a = wsf[crow(r, hi)]; o[0][r] *= a; o[1][r] *= a; }
            }
            bf16x8 pa0, pa1, pa2, pa3; pack_p(p0, p1, pa0, pa1, pa2, pa3);
            const int vb = vrb + jt * SW_VT;
            pv_one<2, 0>(o[0], vb, pa0, pa1, pa2, pa3); pv_one<2, 1>(o[1], vb, pa0, pa1, pa2, pa3);
        }
        if (hi == 0) wsf[32 + r32] = l_reg;
        ATT_LAS float* tf = (ATT_LAS float*)(lds + FL_Q) + wid * 1024;
        u32x4 gq[2][2];
#pragma unroll
        for (int d = 0; d < 2; ++d)
#pragma unroll
            for (int j = 0; j < 2; ++j) gq[d][j] = *(const u32x4*)(A.proj + (tok0 + wid * 32 + 16 * j + (lane >> 2)) * PITCH + C_GB + hq * 64 + 32 * d + 8 * (lane & 3));
#pragma unroll
        for (int d = 0; d < 2; ++d) {
#pragma unroll
            for (int r = 0; r < 16; ++r) tf[crow(r, hi) * 32 + r32] = o[d][r];
            asm volatile("s_waitcnt lgkmcnt(0)" ::: "memory");
#pragma unroll
            for (int j = 0; j < 2; ++j) { const int row = 16 * j + (lane >> 2);
                const f32x4 t0 = *(ATT_LAS const f32x4*)(tf + row * 32 + 8 * (lane & 3)), t1 = *(ATT_LAS const f32x4*)(tf + row * 32 + 8 * (lane & 3) + 4);
                const float rl = 1.0f / wsf[32 + row];
                const u32x4 gw = gq[d][j];
#define GLO(w) __uint_as_float((w) << 16)
#define GHI(w) __uint_as_float((w) & 0xffff0000u)
                u32x4 ov; ov.x = cvtpk(t0.x * rl * GLO(gw.x), t0.y * rl * GHI(gw.x)); ov.y = cvtpk(t0.z * rl * GLO(gw.y), t0.w * rl * GHI(gw.y));
                ov.z = cvtpk(t1.x * rl * GLO(gw.z), t1.y * rl * GHI(gw.z)); ov.w = cvtpk(t1.z * rl * GLO(gw.w), t1.w * rl * GHI(gw.w));
#undef GLO
#undef GHI
                *(u32x4*)(A.merged + (tok0 + wid * 32 + row) * DM + hq * 64 + 32 * d + 8 * (lane & 3)) = ov; }
            asm volatile("s_waitcnt lgkmcnt(0)" ::: "memory");
        }
    }
}

__device__ __forceinline__ void flash_item(const AttnArgs& A, int b, int h, int c, int qb, ATT_LAS char* lds) {
    const int tid = pg8::otid(), lane = tid & 63, r32 = lane & 31, hi = lane >> 5; const int wid = __builtin_amdgcn_readfirstlane(tid >> 6);
    const int q0 = qb * 256; const size_t tok0 = (size_t)b * SEQ + q0;
    const float slope2 = __builtin_amdgcn_exp2f(-2.0f * (float)(h + 1)) * LOG2E;
    const bf16_t* Qw = A.proj + (tok0 + wid * 32 + r32) * PITCH + C_QA + h * 256 + c * 128 + hi * 8;
    const bf16_t* Kb = A.proj + (size_t)b * SEQ * PITCH + C_KA + h * 256 + c * 128;
    const bf16_t* Vb = A.proj + (size_t)b * SEQ * PITCH + C_VA + h * 256;
    const float kmax = sqrtf(__uint_as_float(__hip_atomic_load(A.kmax2 + (b * 4 + h) * 2 + c, __ATOMIC_RELAXED, __HIP_MEMORY_SCOPE_AGENT)));
    f32x16 o[8];
    flash_map(o, Qw, Kb, Vb, q0, slope2, kmax, lds);
    constexpr int OT_LD = 272;
    __syncthreads();
    ATT_LAS char* tb = lds + wid * (32 * OT_LD);
    bf16_t* orow = A.oc + (size_t)c * TOK * DM + (tok0 + wid * 32) * DM + h * 256;
#pragma unroll
    for (int half = 0; half < 2; ++half) {
#pragma unroll
        for (int r = 0; r < 16; ++r)
#pragma unroll
            for (int dd = 0; dd < 4; ++dd) *(ATT_LAS bf16_t*)(tb + crow(r, hi) * OT_LD + (32 * dd + r32) * 2) = (bf16_t)(cvtpk(o[4 * half + dd][r], 0.f) & 0xffffu);
        asm volatile("s_waitcnt lgkmcnt(0)" ::: "memory");
        u32x4 pc[8];
#pragma unroll
        for (int j = 0; j < 8; ++j) pc[j] = *(ATT_LAS const u32x4*)(tb + (4 * j + (lane >> 4)) * OT_LD + (lane & 15) * 16);
        asm volatile("s_waitcnt lgkmcnt(0)" ::: "memory");
#pragma unroll
        for (int j = 0; j < 8; ++j) *(u32x4*)(orow + (size_t)(4 * j + (lane >> 4)) * DM + 128 * half + 8 * (lane & 15)) = pc[j];
    }
}
#undef SBAR
}

constexpr int NWAVES = 8;
constexpr int PPL = 10;
constexpr int NPHASE = 1 + PPL * DEPTH;
constexpr size_t MiB = 1u << 20;
constexpr size_t al_mib(size_t x) { return (x + MiB - 1) / MiB * MiB; }
constexpr size_t WS_CTL  = 0,                         CTL_ZERO_BYTES = 1 * MiB;
constexpr size_t WS_WIN  = WS_CTL + CTL_ZERO_BYTES,   SZ_WIN  = al_mib((size_t)DEPTH * DIN * DM + (size_t)DEPTH * DIN * 4);
constexpr size_t WS_WO   = WS_WIN + SZ_WIN,           SZ_WO   = al_mib((size_t)DEPTH * DM * DM + (size_t)DEPTH * DM * 4);
constexpr size_t WS_WUP  = WS_WO + SZ_WO,             SZ_WUP  = al_mib((size_t)DEPTH * NEXP * 2 * DFF * DM + (size_t)DEPTH * NEXP * 2 * DFF * 4);
constexpr size_t WS_WDN  = WS_WUP + SZ_WUP,           SZ_WDN  = al_mib((size_t)DEPTH * NEXP * DM * DFF * 2);
constexpr size_t WS_XB   = WS_WDN + SZ_WDN,           SZ_XB   = al_mib((size_t)TOK * DM + (size_t)TOK * 4);
constexpr size_t WS_XF   = WS_XB + SZ_XB,             SZ_XF   = al_mib((size_t)TOK * DM * 4);
constexpr size_t WS_PROJ = WS_XF + SZ_XF,             SZ_PROJ = al_mib((size_t)TOK * DIN * 2);
constexpr size_t WS_MRG  = WS_PROJ + SZ_PROJ,         SZ_MRG  = al_mib((size_t)TOK * DM * 2 + (size_t)TOK * DM + (size_t)TOK * 4);
constexpr size_t WS_MIX  = WS_MRG + SZ_MRG,           SZ_MIX  = al_mib((size_t)TOK * DM * 2);
constexpr size_t WS_HF   = WS_MIX + SZ_MIX,           SZ_HF   = al_mib((size_t)TOK * DM * 4);
constexpr size_t WS_HB   = WS_HF + SZ_HF,             SZ_HB   = al_mib((size_t)TOK * DM + (size_t)TOK * 4 + (size_t)MAXBLK * 256 * 4);
constexpr size_t WS_EID  = WS_HB + SZ_HB,             SZ_EID  = al_mib((size_t)TK * 4);
constexpr size_t WS_GATE = WS_EID + SZ_EID,           SZ_GATE = al_mib((size_t)TK * 4);
constexpr size_t WS_DEST = WS_GATE + SZ_GATE,         SZ_DEST = al_mib((size_t)TK * 4);
constexpr size_t WS_CNT  = WS_DEST + SZ_DEST,         SZ_CNT  = MiB;
constexpr size_t WS_XG   = WS_CNT + SZ_CNT,           SZ_XG   = al_mib((size_t)MAXBLK * 256 * DM * 2);
constexpr size_t WS_ACT  = WS_XG + SZ_XG,             SZ_ACT  = al_mib((size_t)MAXBLK * 256 * DFF * 2);
constexpr size_t WS_Y    = WS_ACT + SZ_ACT,           SZ_Y    = al_mib((size_t)MAXBLK * 256 * DM * 2);
constexpr size_t WS_OSCR = WS_Y + SZ_Y,               SZ_OSCR = al_mib((size_t)2 * TOK * DM * 2);
constexpr size_t WS_END  = WS_OSCR + SZ_OSCR;
constexpr int NCHUNK = TOK / 128;
constexpr int CNT_BLKE = NCHUNK * NEXP, CNT_NBLK = CNT_BLKE + MAXBLK, CNT_TOKL = 16384;
static_assert((CNT_TOKL + MAXBLK * 256) * 4 <= (int)MiB && CNT_NBLK < CNT_TOKL, "CNT region");
constexpr int CW_BAR = 4096;
constexpr int CW_KMAX = 8192;
constexpr int CW_QHEAD = 8448;
constexpr int RING_OFF = 0, RING_BYTES = 158720;
constexpr int LDSCTL_OFF = RING_BYTES, MISC_OFF = LDSCTL_OFF + 320;
constexpr int LDS_BYTES = 163840;
static_assert(att::ATT_LDS <= RING_BYTES, "attention LDS");

#define GAS __attribute__((address_space(1)))
#define LAS __attribute__((address_space(3)))
typedef unsigned short bf16;
typedef unsigned v4u __attribute__((ext_vector_type(4)));
typedef float f32x4 __attribute__((ext_vector_type(4)));
typedef short bf16x8 __attribute__((ext_vector_type(8)));
typedef GAS unsigned gu32;
typedef GAS unsigned long long gu64;
#define RLX_AGENT __ATOMIC_RELAXED, __HIP_MEMORY_SCOPE_AGENT
#define LDS_WAIT() asm volatile("s_waitcnt lgkmcnt(0)" ::: "memory")
#define VM_WAIT() asm volatile("s_waitcnt vmcnt(0)" ::: "memory")
__device__ __forceinline__ unsigned long long rt() { return __builtin_amdgcn_s_memrealtime(); }
__device__ __forceinline__ unsigned f2bf(float f) { unsigned u = __builtin_bit_cast(unsigned, f); return (u + 0x7fffu + ((u >> 16) & 1u)) >> 16; }
__device__ __forceinline__ unsigned pk2(float lo, float hi) { return f2bf(lo) | (f2bf(hi) << 16); }
#define XB_TMO      128
#define XB_XCNT(j)  (256  + 64 * (j))
#define XB_XSUB(j)  (1280 + 64 * (j))
#define XB_XGEN(j)  (2304 + 64 * (j))
#define XB_TOP      3328
#define XB_TOPGEN   3392
#define XCD_BAR_WORDS 3456
#define XB_SPIN_CAP (1u << 18)

__device__ __forceinline__ unsigned xb_ld(unsigned* p)              { return __hip_atomic_load(p, __ATOMIC_RELAXED, __HIP_MEMORY_SCOPE_AGENT); }
__device__ __forceinline__ unsigned xb_add(unsigned* p, unsigned v) { return __hip_atomic_fetch_add(p, v, __ATOMIC_RELAXED, __HIP_MEMORY_SCOPE_AGENT); }
__device__ __forceinline__ unsigned xb_xcc_id() { return (unsigned)__builtin_amdgcn_s_getreg((3 << 11) | 20) & 0xFu; }
#define XB_SPIN(cond, bar) do { unsigned _sp = 0; while (cond) { __builtin_amdgcn_s_sleep(1); \
    if ((++_sp & 255u) == 0u) { if (xb_ld(&(bar)[XB_TMO])) break; if (_sp > XB_SPIN_CAP) { atomicAdd(&(bar)[XB_TMO], 1u); break; } } } } while (0)

struct XcdBarrier {
    unsigned* bar; unsigned x;
    volatile LAS unsigned* st;
};

__device__ __forceinline__ XcdBarrier xcd_barrier_post(unsigned* bar, volatile LAS unsigned* st) {
    XcdBarrier b; b.bar = bar; b.x = xb_xcc_id(); b.st = st;
    if (threadIdx.x == 0) (void)xb_add(&bar[XB_XCNT(b.x)], 1u);
    return b;
}
__device__ __forceinline__ void xcd_barrier_complete(unsigned* bar, unsigned x, unsigned& nloc, unsigned& nx) {
    const unsigned G = gridDim.x * gridDim.y * gridDim.z;
    unsigned sum, cnt, mine, sp = 0u;
    for (;;) {
        sum = 0u; cnt = 0u; mine = 0u;
#pragma unroll
        for (unsigned j = 0; j < 16; ++j) { const unsigned c = xb_ld(&bar[XB_XCNT(j)]); sum += c; cnt += (c > 0u) ? 1u : 0u; mine = (j == x) ? c : mine; }
        if (sum == G) break;
        __builtin_amdgcn_s_sleep(1);
        if ((++sp & 255u) == 0u) { if (xb_ld(&bar[XB_TMO])) break; if (sp > XB_SPIN_CAP) { atomicAdd(&bar[XB_TMO], 1u); break; } }
    }
    nloc = mine > 0u ? mine : 1u; nx = cnt > 0u ? cnt : 1u;
}

__device__ __forceinline__ void xcd_barrier(const XcdBarrier& b) {
    asm volatile("s_waitcnt vmcnt(0)" ::: "memory");
    __syncthreads();
    if (threadIdx.x == 0) {
        unsigned* bar = b.bar;
        __builtin_amdgcn_s_waitcnt(0);
        unsigned nloc = b.st[0], nx = b.st[1];
        if (nloc == 0u) { xcd_barrier_complete(bar, b.x, nloc, nx); b.st[0] = nloc; b.st[1] = nx; }
        const unsigned old = xb_add(&bar[XB_XSUB(b.x)], 1u);
        const unsigned gen = old / nloc;
        if (old + 1u == (gen + 1u) * nloc) {
            __builtin_amdgcn_fence(__ATOMIC_RELEASE, "agent");
            asm volatile("s_waitcnt vmcnt(0)" ::: "memory");
            const unsigned og = xb_add(&bar[XB_TOP], 1u);
            const unsigned tg = og / nx;
            if (og + 1u == (tg + 1u) * nx) xb_add(&bar[XB_TOPGEN], 1u);
            else XB_SPIN(xb_ld(&bar[XB_TOPGEN]) == tg, bar);
            __builtin_amdgcn_fence(__ATOMIC_ACQUIRE, "agent");
            xb_add(&bar[XB_XGEN(b.x)], 1u);
            asm volatile("s_waitcnt vmcnt(0)" ::: "memory");
        } else {
            XB_SPIN(xb_ld(&bar[XB_XGEN(b.x)]) == gen, bar);
            __builtin_amdgcn_fence(__ATOMIC_ACQUIRE, "agent");
            asm volatile("s_waitcnt vmcnt(0)" ::: "memory");
        }
    }
    __syncthreads();
}


#define DPP_F(v_, ctrl_) __int_as_float(__builtin_amdgcn_update_dpp(0, __float_as_int(v_), ctrl_, 0xf, 0xf, true))
__device__ __forceinline__ float wave_sum(float v) {
    v += DPP_F(v, 0xB1); v += DPP_F(v, 0x4E); v += DPP_F(v, 0x124); v += DPP_F(v, 0x128);
    const int b = __float_as_int(v);
    return (__int_as_float(__builtin_amdgcn_readlane(b, 0)) + __int_as_float(__builtin_amdgcn_readlane(b, 16))) + (__int_as_float(__builtin_amdgcn_readlane(b, 32)) + __int_as_float(__builtin_amdgcn_readlane(b, 48)));
}
__device__ __forceinline__ void p0_transpose_item(const float* W, int K, int N, bf16* WT, LAS float* scr, int item, int lane) {
    const int nblk = N / 32, kb = item / nblk, nb = item % nblk, k0 = 64 * kb, n0 = 32 * nb;
    { const int c4 = lane & 7, rsub = lane >> 3;
#pragma unroll
      for (int i = 0; i < 8; ++i) { const int kk = 8 * i + rsub; const f32x4 v = *(const f32x4*)(W + (size_t)(k0 + kk) * N + n0 + 4 * c4);
          scr[kk * 33 + 4 * c4 + 0] = v.x; scr[kk * 33 + 4 * c4 + 1] = v.y; scr[kk * 33 + 4 * c4 + 2] = v.z; scr[kk * 33 + 4 * c4 + 3] = v.w; } }
    LDS_WAIT(); asm volatile("" ::: "memory");
    const int c = lane & 7;
#pragma unroll
    for (int j = 0; j < 4; ++j) { const int n = (lane >> 3) + 8 * j; const LAS float* s = scr + (8 * c) * 33 + n;
        v4u o; o.x = pk2(s[0 * 33], s[1 * 33]); o.y = pk2(s[2 * 33], s[3 * 33]); o.z = pk2(s[4 * 33], s[5 * 33]); o.w = pk2(s[6 * 33], s[7 * 33]);
        *(GAS v4u*)(WT + (size_t)(n0 + n) * K + k0 + 8 * c) = o; }
    LDS_WAIT(); asm volatile("" ::: "memory");
}

__device__ __forceinline__ int q8(float v, float inv) { return (int)__builtin_rintf(fminf(fmaxf(v * inv, -127.f), 127.f)); }
__device__ __forceinline__ unsigned pack4(int a, int b, int c, int d) { return ((unsigned)a & 255u) | (((unsigned)b & 255u) << 8) | (((unsigned)c & 255u) << 16) | ((unsigned)d << 24); }
__device__ __forceinline__ float wave_max(float v) {
    v = fmaxf(v, DPP_F(v, 0xB1)); v = fmaxf(v, DPP_F(v, 0x4E)); v = fmaxf(v, DPP_F(v, 0x124)); v = fmaxf(v, DPP_F(v, 0x128));
    const int b = __float_as_int(v);
    return fmaxf(fmaxf(__int_as_float(__builtin_amdgcn_readlane(b, 0)), __int_as_float(__builtin_amdgcn_readlane(b, 16))), fmaxf(__int_as_float(__builtin_amdgcn_readlane(b, 32)), __int_as_float(__builtin_amdgcn_readlane(b, 48))));
}
__device__ __forceinline__ void quant_row(const f32x4 (&v)[4], signed char* q, float* scale, int lane) {
    float mx = 0.f;
#pragma unroll
    for (int j = 0; j < 4; ++j) mx = fmaxf(fmaxf(fmaxf(mx, fabsf(v[j].x)), fabsf(v[j].y)), fmaxf(fabsf(v[j].z), fabsf(v[j].w)));
    mx = wave_max(mx);
    const float inv = mx > 0.f ? 127.f / mx : 0.f;
#pragma unroll
    for (int j = 0; j < 4; ++j) ((unsigned*)q)[lane + 64 * j] = pack4(q8(v[j].x, inv), q8(v[j].y, inv), q8(v[j].z, inv), q8(v[j].w, inv));
    if (lane == 0) *scale = mx * (1.f / 127.f);
}
struct Args { const float* in[14]; float* out; unsigned char* ws; int g_lo, g_hi; };

__global__ void __launch_bounds__(NWAVES * 64, 2) mk_fwd(Args args) {
    extern __shared__ __attribute__((aligned(16))) unsigned char lds_raw[];
    LAS unsigned char* lds = (LAS unsigned char*)lds_raw;
    volatile LAS unsigned* MISC = (volatile LAS unsigned*)(lds + MISC_OFF);
    const int tid0 = threadIdx.x;
    const int G = gridDim.x; const int vcu = (G % 8 == 0) ? ((int)blockIdx.x % 8) * (G / 8) + (int)blockIdx.x / 8 : (int)blockIdx.x;
    gu32* ctl = (gu32*)(args.ws + WS_CTL);
    for (int u = tid0; u < (LDS_BYTES - LDSCTL_OFF) / 4; u += NWAVES * 64) ((LAS unsigned*)(lds + LDSCTL_OFF))[u] = 0u;
    __syncthreads();
    XcdBarrier bar; bar.bar = (unsigned*)(ctl + CW_BAR); bar.x = 0; bar.st = nullptr;
    if (MK_SINGLE) bar = xcd_barrier_post((unsigned*)(ctl + CW_BAR), MISC + 8);
    const int g_lo = args.g_lo, g_hi = args.g_hi;
#ifndef PH_EN
#define PH_EN 0x7ff
#endif
#ifndef REP_MASK
#define REP_MASK 0
#endif
#define REPS(k) (((REP_MASK >> (k)) & 1) + 1)
#define REP_BEGIN(k) for (int rep_ = 0; rep_ < REPS(k); ++rep_) { if (rep_) xcd_barrier(bar);
#define REP_END() }
#define IN(k) (g_lo <= (k) && (k) < g_hi)
#define BAR_IF(k) do { if (MK_SINGLE && IN(k)) xcd_barrier(bar); } while (0)

#define PHASE_BEGIN() GAS unsigned char* wsg_ = (GAS unsigned char*)args.ws; asm volatile("" : "+s"(wsg_)); unsigned char* ws = (unsigned char*)wsg_;     \
    const int tid = pg8::otid(), lane = tid & 63, wave = __builtin_amdgcn_readfirstlane(tid >> 6); \
    const int gw = vcu * NWAVES + wave, NGW = G * NWAVES; (void)lane; (void)gw; (void)NGW; \
    signed char* WIN_t = (signed char*)(ws + WS_WIN); float* SWIN = (float*)(ws + WS_WIN + (size_t)DEPTH * DIN * DM); signed char* WO_t = (signed char*)(ws + WS_WO); float* SWO = (float*)(ws + WS_WO + (size_t)DEPTH * DM * DM); signed char* WUP_t = (signed char*)(ws + WS_WUP); float* SWUP = (float*)(ws + WS_WUP + (size_t)DEPTH * NEXP * 2 * DFF * DM); bf16* WDN_t = (bf16*)(ws + WS_WDN); \
    signed char* XB = (signed char*)(ws + WS_XB); float* SX = (float*)(ws + WS_XB + (size_t)TOK * DM); float* XF = (float*)(ws + WS_XF); bf16* PROJ = (bf16*)(ws + WS_PROJ); bf16* MRG = (bf16*)(ws + WS_MRG); signed char* MRG8 = (signed char*)(ws + WS_MRG + (size_t)TOK * DM * 2); float* SM = (float*)(ws + WS_MRG + (size_t)TOK * DM * 3); \
    bf16* MIX = (bf16*)(ws + WS_MIX); float* HF = (float*)(ws + WS_HF); signed char* HB = (signed char*)(ws + WS_HB); float* SH = (float*)(ws + WS_HB + (size_t)TOK * DM); float* SHP = SH + TOK; \
    int* EID = (int*)(ws + WS_EID); float* GATE = (float*)(ws + WS_GATE); int* DEST = (int*)(ws + WS_DEST); int* CNT = (int*)(ws + WS_CNT); \
    bf16* XG = (bf16*)(ws + WS_XG); bf16* ACT = (bf16*)(ws + WS_ACT); bf16* Y = (bf16*)(ws + WS_Y); bf16* OSCR = (bf16*)(ws + WS_OSCR); \
    (void)WIN_t; (void)SWO; (void)MRG8; (void)SM; (void)SWIN; (void)SX; (void)SWUP; (void)SH; (void)SHP; (void)WO_t; (void)WUP_t; (void)WDN_t; (void)XB; (void)XF; (void)PROJ; (void)MRG; (void)MIX; (void)HF; (void)HB; (void)EID; (void)GATE; (void)DEST; (void)CNT; (void)XG; (void)ACT; (void)Y; (void)OSCR

    if ((PH_EN & 1) && IN(0)) {
        PHASE_BEGIN();
            REP_BEGIN(0)
        LAS float* scr = (LAS float*)(lds + RING_OFF + wave * 16384);
        for (int m = gw; m < TOK; m += NGW) {
            const GAS f32x4* xr = (const GAS f32x4*)(args.in[0] + (size_t)m * DM) + lane; f32x4 v[4];
#pragma unroll
            for (int j = 0; j < 4; ++j) v[j] = xr[64 * j];
            quant_row(v, XB + (size_t)m * DM, SX + m, lane);
        }
        {
            constexpr int P_IN = DEPTH * (DIN / 32), P_UP = DEPTH * NEXP * (2 * DFF / 32), P_WO = DEPTH * (DM / 32);
            LAS float* P = (LAS float*)(lds + RING_OFF); LAS unsigned* cm = (LAS unsigned*)(lds + RING_OFF + DM * 33 * 4);
            for (int pnl = vcu; pnl < P_IN + P_UP + P_WO; pnl += G) {
                const float* W; int n0, DIN_; signed char* W8; float* SWp;
                if (pnl < P_IN) { const int l = pnl / (DIN / 32); n0 = (pnl % (DIN / 32)) * 32; DIN_ = DIN; W = args.in[1] + (size_t)l * DM * DIN; W8 = WIN_t + (size_t)l * DIN * DM; SWp = SWIN + (size_t)l * DIN; }
                else if (pnl < P_IN + P_UP) { const int q = pnl - P_IN, le = q / (2 * DFF / 32); n0 = (q % (2 * DFF / 32)) * 32; DIN_ = 2 * DFF; W = args.in[10] + (size_t)le * DM * 2 * DFF; W8 = WUP_t + (size_t)le * 2 * DFF * DM; SWp = SWUP + (size_t)le * 2 * DFF; }
                else { const int q = pnl - P_IN - P_UP, lw = q / (DM / 32); n0 = (q % (DM / 32)) * 32; DIN_ = DM; W = args.in[2] + (size_t)lw * DM * DM; W8 = WO_t + (size_t)lw * DM * DM; SWp = SWO + (size_t)lw * DM; }
                __syncthreads();
                if (tid < 32) cm[tid] = 0u;
                const int c4 = tid & 7, r0 = tid >> 3;
                const float* Wc = W + n0 + 4 * c4 + (size_t)r0 * DIN_;
                f32x4 v[16];
#pragma unroll
                for (int i = 0; i < 16; ++i) v[i] = *(const f32x4*)(Wc + (size_t)(64 * i) * DIN_);
                __syncthreads();
                f32x4 mx = {0.f, 0.f, 0.f, 0.f};
#pragma unroll
                for (int i = 0; i < 16; ++i) { LAS float* d = P + (r0 + 64 * i) * 33 + 4 * c4; d[0] = v[i].x; d[1] = v[i].y; d[2] = v[i].z; d[3] = v[i].w;
                    mx.x = fmaxf(mx.x, fabsf(v[i].x)); mx.y = fmaxf(mx.y, fabsf(v[i].y)); mx.z = fmaxf(mx.z, fabsf(v[i].z)); mx.w = fmaxf(mx.w, fabsf(v[i].w)); }
                __hip_atomic_fetch_max(cm + 4 * c4 + 0, __float_as_uint(mx.x), __ATOMIC_RELAXED, __HIP_MEMORY_SCOPE_WORKGROUP); __hip_atomic_fetch_max(cm + 4 * c4 + 1, __float_as_uint(mx.y), __ATOMIC_RELAXED, __HIP_MEMORY_SCOPE_WORKGROUP);
                __hip_atomic_fetch_max(cm + 4 * c4 + 2, __float_as_uint(mx.z), __ATOMIC_RELAXED, __HIP_MEMORY_SCOPE_WORKGROUP); __hip_atomic_fetch_max(cm + 4 * c4 + 3, __float_as_uint(mx.w), __ATOMIC_RELAXED, __HIP_MEMORY_SCOPE_WORKGROUP);
                __syncthreads();
                if (tid < 32) SWp[n0 + tid] = __uint_as_float(cm[tid]) * (1.f / 127.f);
                const int c = lane & 7;
#pragma unroll
                for (int j = 0; j < 2; ++j) { const int k0 = 128 * wave + 64 * j;
#pragma unroll
                    for (int jj = 0; jj < 4; ++jj) { const int n = (lane >> 3) + 8 * jj; const float cmx = __uint_as_float(cm[n]); const float ivn = cmx > 0.f ? 127.f / cmx : 0.f;
                        const LAS float* s = P + (k0 + 8 * c) * 33 + n;
                        const unsigned w0 = pack4(q8(s[0 * 33], ivn), q8(s[1 * 33], ivn), q8(s[2 * 33], ivn), q8(s[3 * 33], ivn)), w1 = pack4(q8(s[4 * 33], ivn), q8(s[5 * 33], ivn), q8(s[6 * 33], ivn), q8(s[7 * 33], ivn));
                        *(GAS unsigned long long*)(W8 + (size_t)(n0 + n) * DM + k0 + 8 * c) = (unsigned long long)w0 | ((unsigned long long)w1 << 32); } }
            }
            __syncthreads();
        }
        {
            constexpr int P_DN = DEPTH * NEXP * (DM / 32);
            for (int pnl = gw; pnl < P_DN; pnl += NGW) {
                const float* W; int n0; bf16* WB;
                { const int le = pnl / (DM / 32); n0 = (pnl % (DM / 32)) * 32; W = args.in[12] + (size_t)le * DFF * DM; WB = WDN_t + (size_t)le * DM * DFF; }
                const int c4 = lane & 7, rsub = lane >> 3;
                const float* Wc = W + n0 + 4 * c4 + (size_t)rsub * DM;
                f32x4 nx[8];
#pragma unroll
                for (int i = 0; i < 8; ++i) nx[i] = *(const f32x4*)(Wc + (size_t)(8 * i) * DM);
                for (int kb = 0; kb < DM / 64; ++kb) { const int k0 = 64 * kb;
#pragma unroll
                    for (int i = 0; i < 8; ++i) { const int kk = 8 * i + rsub; scr[kk * 33 + 4 * c4 + 0] = nx[i].x; scr[kk * 33 + 4 * c4 + 1] = nx[i].y; scr[kk * 33 + 4 * c4 + 2] = nx[i].z; scr[kk * 33 + 4 * c4 + 3] = nx[i].w; }
                    if (kb + 1 < DM / 64) {
#pragma unroll
                        for (int i = 0; i < 8; ++i) nx[i] = *(const f32x4*)(Wc + (size_t)(k0 + 64 + 8 * i) * DM); }
                    LDS_WAIT(); asm volatile("" ::: "memory");
                    const int c = lane & 7;
#pragma unroll
                    for (int jj = 0; jj < 4; ++jj) { const int n = (lane >> 3) + 8 * jj; const LAS float* s = scr + (8 * c) * 33 + n;
                        v4u o; o.x = pk2(s[0 * 33], s[1 * 33]); o.y = pk2(s[2 * 33], s[3 * 33]); o.z = pk2(s[4 * 33], s[5 * 33]); o.w = pk2(s[6 * 33], s[7 * 33]);
                        *(GAS v4u*)(WB + (size_t)(n0 + n) * DM + k0 + 8 * c) = o; }
                    LDS_WAIT(); asm volatile("" ::: "memory"); }
            }
        }
            REP_END()
        BAR_IF(1);
    }

    for (int l = 0; l < DEPTH; ++l) {
        const int pb = 1 + PPL * l;
        if ((PH_EN & 2) && IN(pb + 0)) {
            PHASE_BEGIN();
            REP_BEGIN(1)
            pg8::Gemm g{(const bf16*)XB, (const bf16*)(WIN_t + (size_t)l * DIN * DM), TOK, DIN, DM / 2, 0, nullptr}; pg8::StaticOrder S; S.init(TOK, DIN, G, (int)blockIdx.x, nullptr);
            pg8::EpiInProjI8 E{PROJ, SX, SWIN + (size_t)l * DIN};
            pg8::gemm_phase<pg8::EpiInProjI8, pg8::StaticOrder, true, true, false, true>(lds + RING_OFF, g, S, E);
            REP_END()
            BAR_IF(pb + 1);
        }
        if ((PH_EN & 4) && IN(pb + 1)) {
            PHASE_BEGIN();
            REP_BEGIN(2)
            LAS unsigned* lmax = (LAS unsigned*)(lds + RING_OFF);
            if (tid < 16) lmax[tid] = 0u;
            __syncthreads();
            for (int b = 0; b < NB; ++b) {
                float mx = 0.f;
                for (int m = gw; m < SEQ; m += NGW) {
                    const bf16* kp = PROJ + ((size_t)b * SEQ + m) * DIN + C_KA + lane * 16;
                    const bf16x8 k0 = *(const bf16x8*)kp, k1 = *(const bf16x8*)(kp + 8);
                    float s = 0.f;
#pragma unroll
                    for (int j = 0; j < 8; ++j) { const float x0 = __uint_as_float((unsigned)(unsigned short)k0[j] << 16), x1 = __uint_as_float((unsigned)(unsigned short)k1[j] << 16); s += x0 * x0 + x1 * x1; }
                    s += __shfl_xor(s, 1); s += __shfl_xor(s, 2); s += __shfl_xor(s, 4);
                    mx = fmaxf(mx, s);
                }
                if ((lane & 7) == 0) __hip_atomic_fetch_max(lmax + b * 8 + (lane >> 3), __float_as_uint(mx), __ATOMIC_RELAXED, __HIP_MEMORY_SCOPE_WORKGROUP);
            }
            __syncthreads();
            if (tid < 16) __hip_atomic_fetch_max((unsigned*)(ctl + CW_KMAX + l * 16 + tid), lmax[tid], RLX_AGENT);
            REP_END()
            BAR_IF(pb + 2);
        }
        if ((PH_EN & 8) && IN(pb + 2)) {
            PHASE_BEGIN();
            REP_BEGIN(3)
            att::AttnArgs A; A.proj = PROJ; A.merged = MRG; A.oc = OSCR; A.lam = 0.f; A.one_m_lam_init = 0.f;
            { const float* sg_ = args.in[4] + (size_t)l * 256; const float* sk_ = args.in[5] + (size_t)l * 16; asm volatile("" : "+s"(sg_), "+s"(sk_)); A.subln_g = sg_; A.sinks = sk_; }
            A.kmax2 = (const unsigned*)(ctl + CW_KMAX + l * 16);
            for (;;) {
                __syncthreads();
                if (tid == 0) MISC[12] = __hip_atomic_fetch_add((unsigned*)(ctl + CW_QHEAD + (l * 2 + rep_) * 64), 1u, RLX_AGENT);
                __syncthreads();
                const int n = __builtin_amdgcn_readfirstlane((int)MISC[12]);
                if (n >= 1536) break;
                if (n < 1024) { const int h = 3 - (n >> 8), rem = n & 255; att::flash_item(A, rem & 1, h, (rem >> 1) & 1, 63 - (rem >> 2), (ATT_LAS char*)(lds + RING_OFF)); }
                else { const int m = n - 1024; att::swa_part(A, m & 1, (m >> 1) & 3, (m >> 3) << 8, (ATT_LAS char*)(lds + RING_OFF)); }
            }
            __syncthreads();
            REP_END()
            BAR_IF(pb + 3);
        }
        if ((PH_EN & 16) && IN(pb + 3)) {
            PHASE_BEGIN();
            REP_BEGIN(4)
            const float* lq = args.in[3] + (size_t)l * 4 * 128;
            float d1 = 0.f, d2 = 0.f;
            for (int i = 0; i < 128; ++i) { d1 += lq[i] * lq[128 + i]; d2 += lq[256 + i] * lq[384 + i]; }
            const float lam_init = 0.8f - 0.6f * expf(-0.3f * (float)l);
            const float lam = expf(d1) - expf(d2) + lam_init;
            const f32x4 gs = *((const f32x4*)(args.in[4] + (size_t)l * 256) + lane) * (1.0f - lam_init);
            const bf16* OC0 = OSCR; const bf16* OC1 = OSCR + (size_t)TOK * DM;
#define BF4(w) ((f32x4){__uint_as_float((unsigned)((w) & 0xffffu) << 16), __uint_as_float((unsigned)(((w) >> 16) & 0xffffu) << 16), __uint_as_float((unsigned)(((w) >> 32) & 0xffffu) << 16), __uint_as_float((unsigned)((w) >> 48) << 16)})
#define CB_LOAD(o0_, o1_, ga_, sw_, m_) do { _Pragma("unroll") for (int j = 0; j < 4; ++j) { o0_[j] = *((const unsigned long long*)(OC0 + (size_t)(m_) * DM) + lane + 64 * j); o1_[j] = *((const unsigned long long*)(OC1 + (size_t)(m_) * DM) + lane + 64 * j); \
                ga_[j] = *((const unsigned long long*)(PROJ + (size_t)(m_) * DIN + C_GA) + lane + 64 * j); sw_[j] = *((const unsigned long long*)(MRG + (size_t)(m_) * DM) + lane + 64 * j); } } while (0)
            if (gw < TOK) {
                int m = gw; unsigned long long oa0[4], oa1[4], gaa[4], swa[4];
                CB_LOAD(oa0, oa1, gaa, swa, m);
                for (; m < TOK; m += NGW) {
                    const int mn = (m + NGW < TOK) ? m + NGW : m;
                    unsigned long long on0[4], on1[4], gan[4], swn[4];
                    CB_LOAD(on0, on1, gan, swn, mn);
                    f32x4 d[4]; float ss[4];
#pragma unroll
                    for (int j = 0; j < 4; ++j) { const f32x4 a0 = BF4(oa0[j]), a1 = BF4(oa1[j]);
                        d[j] = a0 - a1 * lam; ss[j] = (d[j].x * d[j].x + d[j].y * d[j].y) + (d[j].z * d[j].z + d[j].w * d[j].w); }
#pragma unroll
                    for (int j = 0; j < 4; ++j) ss[j] = wave_sum(ss[j]);
#pragma unroll
                    for (int j = 0; j < 4; ++j) { const float rstd = 1.0f / sqrtf(ss[j] * (1.0f / 256.0f) + LN_EPS);
                        const f32x4 g4 = BF4(gaa[j]), s4 = BF4(swa[j]);
                        const f32x4 v = d[j] * rstd * gs;
                        d[j] = (f32x4){v.x * g4.x + s4.x, v.y * g4.y + s4.y, v.z * g4.z + s4.z, v.w * g4.w + s4.w}; }
                    quant_row(d, MRG8 + (size_t)m * DM, SM + m, lane);
#pragma unroll
                    for (int j = 0; j < 4; ++j) { oa0[j] = on0[j]; oa1[j] = on1[j]; gaa[j] = gan[j]; swa[j] = swn[j]; }
                }
            }
#undef CB_LOAD
#undef BF4
            REP_END()
            BAR_IF(pb + 4);
        }
        if ((PH_EN & 32) && IN(pb + 4)) {
            PHASE_BEGIN();
            REP_BEGIN(5)
            pg8::Gemm g{(const bf16*)MRG8, (const bf16*)(WO_t + (size_t)l * DM * DM), TOK, DM, DM / 2, 0, nullptr}; pg8::StaticOrder S; S.init(TOK, DM, G, (int)blockIdx.x, nullptr);
            pg8::EpiBf16I8 E{MIX, DM, SM, SWO + (size_t)l * DM};
            pg8::gemm_phase<pg8::EpiBf16I8, pg8::StaticOrder, true, true, false, true>(lds + RING_OFF, g, S, E);
            REP_END()
            BAR_IF(pb + 5);
        }
        if ((PH_EN & 64) && IN(pb + 5)) {
            PHASE_BEGIN();
            REP_BEGIN(6)
            const float* xin = (l == 0) ? args.in[0] : XF;
            const float* lg_ = args.in[6] + (size_t)(l * 2 + 0) * DM; const float* lb_ = args.in[7] + (size_t)(l * 2 + 0) * DM;
            const float* WR = args.in[8] + (size_t)l * DM * NEXP; const float* BR = args.in[9] + (size_t)l * NEXP;
            constexpr int WT_LD = DM + 4;
            LAS float* Wt = (LAS float*)(lds + RING_OFF); LAS int* lcnt = (LAS int*)(lds + RING_OFF + NEXP * WT_LD * 4);
#pragma unroll 4
            for (int it = 0; it < 16; ++it) { const int k = tid + 512 * (it >> 3), e4 = it & 7; const f32x4 wv = *(const f32x4*)(WR + (size_t)k * NEXP + 4 * e4);
                Wt[(4 * e4 + 0) * WT_LD + k] = wv.x; Wt[(4 * e4 + 1) * WT_LD + k] = wv.y; Wt[(4 * e4 + 2) * WT_LD + k] = wv.z; Wt[(4 * e4 + 3) * WT_LD + k] = wv.w; }
            f32x4 gv[4], bv[4];
#pragma unroll
            for (int j = 0; j < 4; ++j) { gv[j] = *((const f32x4*)lg_ + lane + 64 * j); bv[j] = *((const f32x4*)lb_ + lane + 64 * j); }
            for (int chunk = blockIdx.x; chunk < NCHUNK; chunk += G) {
                if (tid < NEXP) lcnt[tid] = 0;
                __syncthreads();
                const size_t row0 = (size_t)chunk * 128 + wave * 16;
                f32x4 xa[4]; unsigned long long ma[4];
                { const f32x4* xr = (const f32x4*)(xin + row0 * DM) + lane; const unsigned long long* mr = (const unsigned long long*)(MIX + row0 * DM) + lane;
#pragma unroll
                  for (int j = 0; j < 4; ++j) { xa[j] = xr[64 * j]; ma[j] = mr[64 * j]; } }
#pragma unroll 2
                for (int i = 0; i < 16; ++i) {
                    const size_t row = row0 + i; const size_t rown = row0 + (i < 15 ? i + 1 : i);
                    f32x4 xn[4]; unsigned long long mn[4];
                    { const f32x4* xr = (const f32x4*)(xin + rown * DM) + lane; const unsigned long long* mr = (const unsigned long long*)(MIX + rown * DM) + lane;
#pragma unroll
                      for (int j = 0; j < 4; ++j) { xn[j] = xr[64 * j]; mn[j] = mr[64 * j]; } }
                    f32x4 v[4]; float s = 0.f;
#pragma unroll
                    for (int j = 0; j < 4; ++j) { const unsigned long long mw = ma[j];
                        const f32x4 mv = {__uint_as_float((unsigned)(mw & 0xffffu) << 16), __uint_as_float((unsigned)((mw >> 16) & 0xffffu) << 16), __uint_as_float((unsigned)((mw >> 32) & 0xffffu) << 16), __uint_as_float((unsigned)(mw >> 48) << 16)};
                        v[j] = xa[j] * DN_ALPHA + mv; s += (v[j].x + v[j].y) + (v[j].z + v[j].w); }
                    const float mean = wave_sum(s) * (1.f / DM); float s2 = 0.f;
#pragma unroll
                    for (int j = 0; j < 4; ++j) { v[j] = v[j] - mean; s2 += (v[j].x * v[j].x + v[j].y * v[j].y) + (v[j].z * v[j].z + v[j].w * v[j].w); }
                    const float rstd = 1.f / sqrtf(wave_sum(s2) * (1.f / DM) + LN_EPS);
                    f32x4* hr = (f32x4*)(HF + row * DM) + lane;
#pragma unroll
                    for (int j = 0; j < 4; ++j) { v[j] = v[j] * rstd * gv[j] + bv[j]; hr[64 * j] = v[j]; }
                    quant_row(v, HB + row * DM, SH + row, lane);
#pragma unroll
                    for (int j = 0; j < 4; ++j) { xa[j] = xn[j]; ma[j] = mn[j]; }
                }
                VM_WAIT();
                {
                    const int c16 = lane & 15, kq = lane >> 4;
                    const float* hrow = HF + (row0 + c16) * DM + 4 * kq; const LAS float* w0 = Wt + c16 * WT_LD + 4 * kq; const LAS float* w1 = w0 + 16 * WT_LD;
                    f32x4 acc0 = {0.f, 0.f, 0.f, 0.f}, acc1 = {0.f, 0.f, 0.f, 0.f};
                    f32x4 hq[8], aq0[2], aq1[2];
#pragma unroll
                    for (int p = 0; p < 8; ++p) hq[p] = *(const f32x4*)(hrow + 16 * p);
#pragma unroll
                    for (int p = 0; p < 2; ++p) { aq0[p] = *(const LAS f32x4*)(w0 + 16 * p); aq1[p] = *(const LAS f32x4*)(w1 + 16 * p); }
#pragma unroll 1
                    for (int s8 = 0; s8 < 64; s8 += 8) {
#pragma unroll
                        for (int p = 0; p < 8; ++p) {
                            const f32x4 hv = hq[p], a0 = aq0[p & 1], a1 = aq1[p & 1];
                            const int sh = (s8 + 8 + p) & 63, sa = (s8 + 2 + p) & 63;
                            hq[p] = *(const f32x4*)(hrow + 16 * sh); aq0[p & 1] = *(const LAS f32x4*)(w0 + 16 * sa); aq1[p & 1] = *(const LAS f32x4*)(w1 + 16 * sa);
                            __builtin_amdgcn_sched_barrier(0);
#pragma unroll
                            for (int j = 0; j < 4; ++j) { acc0 = __builtin_amdgcn_mfma_f32_16x16x4f32(a0[j], hv[j], acc0, 0, 0, 0); acc1 = __builtin_amdgcn_mfma_f32_16x16x4f32(a1[j], hv[j], acc1, 0, 0, 0); }
                            __builtin_amdgcn_sched_barrier(0);
                        }
                    }
                    float lg[32];
#pragma unroll
                    for (int q = 0; q < 4; ++q)
#pragma unroll
                        for (int r = 0; r < 4; ++r) { lg[4 * q + r] = __shfl(acc0[r], c16 + 16 * q); lg[16 + 4 * q + r] = __shfl(acc1[r], c16 + 16 * q); }
#pragma unroll
                    for (int e = 0; e < 32; ++e) lg[e] += BR[e];
                    int ei[4]; float ev[4];
#pragma unroll
                    for (int k = 0; k < 4; ++k) { float best = -INFINITY; int bi = 0;
#pragma unroll
                        for (int e = 0; e < 32; ++e) if (lg[e] > best) { best = lg[e]; bi = e; }
                        ev[k] = best; ei[k] = bi;
#pragma unroll
                        for (int e = 0; e < 32; ++e) lg[e] = (e == bi) ? -INFINITY : lg[e]; }
                    float w[4], wsum = 0.f;
#pragma unroll
                    for (int k = 0; k < 4; ++k) { w[k] = __builtin_amdgcn_exp2f((ev[k] - ev[0]) * LOG2E); wsum += w[k]; }
                    const float rs = 1.0f / wsum;
                    if (kq == 0) {
                        typedef int i32x4 __attribute__((ext_vector_type(4)));
                        *(i32x4*)(EID + (row0 + c16) * 4) = (i32x4){ei[0], ei[1], ei[2], ei[3]};
                        *(f32x4*)(GATE + (row0 + c16) * 4) = (f32x4){w[0] * rs, w[1] * rs, w[2] * rs, w[3] * rs};
#pragma unroll
                        for (int k = 0; k < 4; ++k) __hip_atomic_fetch_add(lcnt + ei[k], 1, __ATOMIC_RELAXED, __HIP_MEMORY_SCOPE_WORKGROUP);
                    }
                }
                __syncthreads();
                if (tid < NEXP) CNT[chunk * NEXP + tid] = lcnt[tid];
            }
            REP_END()
            BAR_IF(pb + 6);
        }
        if ((PH_EN & 128) && IN(pb + 6)) {
            PHASE_BEGIN();
            REP_BEGIN(7)
            LAS int* stot = (LAS int*)(lds + RING_OFF); LAS int* spre = stot + 512; LAS int* ltot = spre + 512; LAS int* lpre = ltot + 32; LAS int* lstart = lpre + 32;
            LAS int* lbase = lstart + 32; LAS int* lnb = lbase + 32; LAS int* ldest = lnb + 32;
            for (int chunk = blockIdx.x; chunk < NCHUNK; chunk += G) {
                { const int e = tid & 31, part = tid >> 5; int tot = 0, pre = 0;
                  for (int c = part * 16; c < part * 16 + 16; ++c) { const int v = CNT[c * NEXP + e]; tot += v; pre += (c < chunk) ? v : 0; }
                  stot[part * 32 + e] = tot; spre[part * 32 + e] = pre; }
                __syncthreads();
                if (tid < 32) { int tot = 0, pre = 0; for (int p = 0; p < 16; ++p) { tot += stot[p * 32 + tid]; pre += spre[p * 32 + tid]; } ltot[tid] = tot; lpre[tid] = pre; }
                __syncthreads();
                if (tid == 0) { int a = 0; for (int e = 0; e < 32; ++e) { lstart[e] = a; a += (ltot[e] + 255) & ~255; } lnb[0] = a >> 8; }
                __syncthreads();
                if (tid < 32) lbase[tid] = lstart[tid] + lpre[tid];
                if (chunk == 0) {
                    for (int blk = tid; blk < MAXBLK; blk += 512) { int e = 31; for (int q = 31; q >= 0; --q) if (blk * 256 < lstart[q] + ((ltot[q] + 255) & ~255)) e = q; CNT[CNT_BLKE + blk] = e; }
                    if (tid == 0) CNT[CNT_NBLK] = lnb[0];
                }
                __syncthreads();
                { const size_t t = (size_t)chunk * 128 + (tid >> 2); const int k = tid & 3; const int e = EID[t * 4 + k];
                  const int pos = __hip_atomic_fetch_add(lbase + e, 1, __ATOMIC_RELAXED, __HIP_MEMORY_SCOPE_WORKGROUP); DEST[t * 4 + k] = pos; ldest[tid] = pos; }
                __syncthreads();
                CNT[CNT_TOKL + ldest[tid]] = chunk * 128 + (tid >> 2);
                SHP[ldest[tid]] = SH[chunk * 128 + (tid >> 2)];
                if (chunk < NEXP) { const int e = chunk; const int r0 = lstart[e] + ltot[e], r1 = lstart[e] + ((ltot[e] + 255) & ~255);
                    for (int i = r0 + tid; i < r1; i += 512) { CNT[CNT_TOKL + i] = 0; SHP[i] = 0.f; } }
                __syncthreads();
            }
            REP_END()
            BAR_IF(pb + 7);
        }
        if ((PH_EN & 256) && IN(pb + 7)) {
            PHASE_BEGIN();
            REP_BEGIN(8)
            const int nblk = __builtin_amdgcn_readfirstlane(__hip_atomic_load(CNT + CNT_NBLK, RLX_AGENT));
            pg8::Gemm g{(const bf16*)HB, (const bf16*)(WUP_t + (size_t)l * NEXP * 2 * DFF * DM), nblk * 256, 2 * DFF, DM / 2, (size_t)2 * DFF * DM, CNT + CNT_TOKL}; pg8::StaticOrder S; S.init(nblk * 256, 2 * DFF, G, (int)blockIdx.x, CNT + CNT_BLKE);
            pg8::EpiSwiGLUI8 E{ACT, args.in[11] + (size_t)l * NEXP * 2 * DFF, SHP, SWUP + (size_t)l * NEXP * 2 * DFF};
            pg8::gemm_phase<pg8::EpiSwiGLUI8, pg8::StaticOrder, true, true, true, true>(lds + RING_OFF, g, S, E);
            REP_END()
            BAR_IF(pb + 8);
        }
        if ((PH_EN & 512) && IN(pb + 8)) {
            PHASE_BEGIN();
            REP_BEGIN(9)
            const int nblk = __builtin_amdgcn_readfirstlane(__hip_atomic_load(CNT + CNT_NBLK, RLX_AGENT));
            pg8::Gemm g{ACT, WDN_t + (size_t)l * NEXP * DM * DFF, nblk * 256, DM, DFF, (size_t)DM * DFF * 2, nullptr}; pg8::StaticOrder S; S.init(nblk * 256, DM, G, (int)blockIdx.x, CNT + CNT_BLKE);
            pg8::EpiBf16Bias E{Y, DM, args.in[13] + (size_t)l * NEXP * DM, DM};
            pg8::gemm_phase<pg8::EpiBf16Bias, pg8::StaticOrder, true, true>(lds + RING_OFF, g, S, E);
            REP_END()
            BAR_IF(pb + 9);
        }
        if ((PH_EN & 1024) && IN(pb + 9)) {
            PHASE_BEGIN();
            REP_BEGIN(10)
            const float* lg_ = args.in[6] + (size_t)(l * 2 + 1) * DM; const float* lb_ = args.in[7] + (size_t)(l * 2 + 1) * DM;
            float* xo = (l == DEPTH - 1) ? args.out : XF;
            f32x4 gv[4], bv[4];
#pragma unroll
            for (int j = 0; j < 4; ++j) { gv[j] = *((const f32x4*)lg_ + lane + 64 * j); bv[j] = *((const f32x4*)lb_ + lane + 64 * j); }
            typedef int i32x4 __attribute__((ext_vector_type(4)));
#define BF4(w) ((f32x4){__uint_as_float((unsigned)((w) & 0xffffu) << 16), __uint_as_float((unsigned)(((w) >> 16) & 0xffffu) << 16), __uint_as_float((unsigned)(((w) >> 32) & 0xffffu) << 16), __uint_as_float((unsigned)((w) >> 48) << 16)})
#define T3_LOAD(h_, y_, m_, dd_) do { const f32x4* hr_ = (const f32x4*)(HF + (size_t)(m_) * DM) + lane; \
                const unsigned long long* y0_ = (const unsigned long long*)(Y + (size_t)(dd_).x * DM) + lane; const unsigned long long* y1_ = (const unsigned long long*)(Y + (size_t)(dd_).y * DM) + lane; \
                const unsigned long long* y2_ = (const unsigned long long*)(Y + (size_t)(dd_).z * DM) + lane; const unsigned long long* y3_ = (const unsigned long long*)(Y + (size_t)(dd_).w * DM) + lane; \
                _Pragma("unroll") for (int j = 0; j < 4; ++j) { h_[j] = hr_[64 * j]; y_[0][j] = y0_[64 * j]; y_[1][j] = y1_[64 * j]; y_[2][j] = y2_[64 * j]; y_[3][j] = y3_[64 * j]; } } while (0)
            if (gw < TOK) {
                int m = gw; int m1 = (m + NGW < TOK) ? m + NGW : m;
                i32x4 dd = *(const i32x4*)(DEST + (size_t)m * 4); f32x4 gg = *(const f32x4*)(GATE + (size_t)m * 4);
                i32x4 dd1 = *(const i32x4*)(DEST + (size_t)m1 * 4); f32x4 gg1 = *(const f32x4*)(GATE + (size_t)m1 * 4);
                f32x4 ha[4]; unsigned long long ya[4][4];
                T3_LOAD(ha, ya, m, dd);
                for (; m < TOK; m += NGW) {
                    f32x4 hn[4]; unsigned long long yn[4][4];
                    T3_LOAD(hn, yn, m1, dd1);
                    const int m2 = (m1 + NGW < TOK) ? m1 + NGW : m1;
                    const i32x4 dd2 = *(const i32x4*)(DEST + (size_t)m2 * 4); const f32x4 gg2 = *(const f32x4*)(GATE + (size_t)m2 * 4);
                    f32x4 v[4]; float s = 0.f;
#pragma unroll
                    for (int j = 0; j < 4; ++j) { v[j] = ha[j] * DN_ALPHA + (BF4(ya[0][j]) * gg.x + BF4(ya[1][j]) * gg.y + BF4(ya[2][j]) * gg.z + BF4(ya[3][j]) * gg.w); s += (v[j].x + v[j].y) + (v[j].z + v[j].w); }
                    const float mean = wave_sum(s) * (1.f / DM); float s2 = 0.f;
#pragma unroll
                    for (int j = 0; j < 4; ++j) { v[j] = v[j] - mean; s2 += (v[j].x * v[j].x + v[j].y * v[j].y) + (v[j].z * v[j].z + v[j].w * v[j].w); }
                    const float rstd = 1.f / sqrtf(wave_sum(s2) * (1.f / DM) + LN_EPS);
                    f32x4* xr = (f32x4*)(xo + (size_t)m * DM) + lane;
#pragma unroll
                    for (int j = 0; j < 4; ++j) { v[j] = v[j] * rstd * gv[j] + bv[j]; xr[64 * j] = v[j]; }
                    if (l + 1 < DEPTH) quant_row(v, XB + (size_t)m * DM, SX + m, lane);
#pragma unroll
                    for (int j = 0; j < 4; ++j) { ha[j] = hn[j]; ya[0][j] = yn[0][j]; ya[1][j] = yn[1][j]; ya[2][j] = yn[2][j]; ya[3][j] = yn[3][j]; }
                    gg = gg1; gg1 = gg2; dd1 = dd2; m1 = m2;
                }
            }
#undef T3_LOAD
#undef BF4
            REP_END()
            BAR_IF(pb + 10);
        }
    }
#undef IN
#undef BAR_IF
}

extern "C" void kernel_launch(void* const* d_in, const int* in_sizes, int n_in, void* d_out, int out_size, void* d_ws, size_t ws_size, hipStream_t stream) {
    static int grid = 0;
    if (grid == 0) {
        if (n_in != 14 || in_sizes[0] != TOK * DM || out_size != TOK * DM || ws_size < WS_END) { fprintf(stderr, "kernel_launch: shape/workspace mismatch (n_in %d, in0 %d, out %d, ws %zu, need %zu)\n", n_in, n_in > 0 ? in_sizes[0] : -1, out_size, ws_size, (size_t)WS_END); grid = -1; return; }
        int dev = 0, cus = 0, per_cu = 0;
        if (hipGetDevice(&dev) != hipSuccess || hipDeviceGetAttribute(&cus, hipDeviceAttributeMultiprocessorCount, dev) != hipSuccess) { grid = -1; return; }
        if (hipFuncSetAttribute((const void*)mk_fwd, hipFuncAttributeMaxDynamicSharedMemorySize, LDS_BYTES) != hipSuccess) { fprintf(stderr, "kernel_launch: hipFuncSetAttribute failed\n"); grid = -1; return; }
        if (hipOccupancyMaxActiveBlocksPerMultiprocessor(&per_cu, (const void*)mk_fwd, NWAVES * 64, LDS_BYTES) != hipSuccess || per_cu < 1) fprintf(stderr, "kernel_launch: occupancy query reports %d\n", per_cu);
        (void)hipGetLastError();
        grid = cus > 256 ? 256 : cus;
    }
    if (grid < 0) return;
    if (hipMemsetAsync((char*)d_ws + WS_CTL, 0, CTL_ZERO_BYTES, stream) != hipSuccess) return;
    Args a{};
    for (int i = 0; i < 14; ++i) a.in[i] = (const float*)d_in[i];
    a.out = (float*)d_out; a.ws = (unsigned char*)d_ws;
#if MK_SINGLE
    a.g_lo = 0; a.g_hi = NPHASE;
    hipLaunchKernelGGL(mk_fwd, dim3(grid), dim3(NWAVES * 64), LDS_BYTES, stream, a);
#else
    for (int g = 0; g < NPHASE; ++g) { a.g_lo = g; a.g_hi = g + 1; hipLaunchKernelGGL(mk_fwd, dim3(grid), dim3(NWAVES * 64), LDS_BYTES, stream, a); }
#endif
    const hipError_t le = hipPeekAtLastError();
    if (le != hipSuccess) fprintf(stderr, "kernel_launch: launch failed: %s\n", hipGetErrorName(le));
}
```
